# Optimizing an MI355X kernel written in HIP

```python
import jax, jax.numpy as jnp
from jax import lax
import numpy as np

D_MODEL = 1024
BATCH = 8
SEQ = 4096
DEPTH = 1

D_MIX = D_MODEL
D_CONV = D_MIX // 2
D_REC = D_MIX - D_CONV
CONV_WIDTH = 31
REC_EXPAND = 128
REC_HEADS = D_REC // REC_EXPAND
REC_DK = REC_EXPAND
REC_DV = D_REC // REC_HEADS
CHUNK = 64
D_IN = 2 * D_CONV + 4 * D_REC
IN_SPLITS = (D_CONV, 2 * D_CONV, 2 * D_CONV + D_REC, 2 * D_CONV + 2 * D_REC, 2 * D_CONV + 3 * D_REC)
N_GROUPS = 4
EXPERTS_PER_GROUP = 8
N_EXPERTS = N_GROUPS * EXPERTS_PER_GROUP
TOP_K = 2
D_EXPERT = D_MODEL // 4
EXPERT_BLOCK = 128
EPS = 1e-6

kernel_name = "hybrid_conv_hgrn2_hmoe_adaln"


def rms_norm(x, gain):
    xf = x.astype(jnp.float32)
    y = xf * lax.rsqrt(jnp.mean(xf * xf, axis=-1, keepdims=True) + EPS)
    return (y * gain.astype(jnp.float32)).astype(x.dtype)


def layer_norm(x, gain, bias):
    xf = x.astype(jnp.float32)
    mu = jnp.mean(xf, axis=-1, keepdims=True)
    xc = xf - mu
    y = xc * lax.rsqrt(jnp.mean(xc * xc, axis=-1, keepdims=True) + EPS)
    return (y * gain.astype(jnp.float32) + bias.astype(jnp.float32)).astype(x.dtype)


def conv_module(val, gate, dw_kernel, dw_bias, ln_gain, ln_bias):
    u = val * jax.nn.sigmoid(gate)
    u = lax.conv_general_dilated(
        u, dw_kernel[:, None, :].astype(u.dtype), window_strides=(1,),
        padding=[(CONV_WIDTH - 1, 0)],
        dimension_numbers=('NWC', 'WIO', 'NWC'),
        feature_group_count=D_CONV) + dw_bias.astype(u.dtype)
    u = layer_norm(u, ln_gain, ln_bias)
    return jax.nn.silu(u)


def hgrn2(q, f_logit, i, g, lb, norm_gain):
    B, S, _ = q.shape
    N = S // CHUNK
    out_dtype = q.dtype
    f32 = jnp.float32
    qf = jax.nn.silu(q.astype(f32))
    forget = lb + (1.0 - lb) * jax.nn.sigmoid(f_logit.astype(f32))
    k = 1.0 - forget
    log_f = jnp.log(forget)

    def heads(t, d):
        return t.reshape(B, N, CHUNK, REC_HEADS, d).transpose(0, 3, 1, 2, 4)

    qh, kh, lfh = heads(qf, REC_DK), heads(k, REC_DK), heads(log_f, REC_DK)
    vh = heads(i.astype(f32), REC_DV)
    b = jnp.cumsum(lfh, axis=3)
    b_last = b[:, :, :, -1:, :]
    q_dec = qh * jnp.exp(b)
    k_inv = kh * jnp.exp(-b)
    scores = jnp.einsum('bhncd,bhnsd->bhncs', q_dec, k_inv)
    causal = jnp.tril(jnp.ones((CHUNK, CHUNK), dtype=bool))
    scores = jnp.where(causal, scores, 0.0)
    o_intra = jnp.einsum('bhncs,bhnse->bhnce', scores, vh)

    k_end = kh * jnp.exp(b_last - b)
    chunk_state = jnp.einsum('bhncd,bhnce->nbhde', k_end, vh)
    chunk_decay = jnp.exp(b_last[:, :, :, 0, :]).transpose(2, 0, 1, 3)

    def step(state, inp):
        d_state, a = inp
        return state * a[..., None] + d_state, state

    s0 = jnp.zeros((B, REC_HEADS, REC_DK, REC_DV), f32)
    _, s_prev = lax.scan(step, s0, (chunk_state, chunk_decay))
    o_inter = jnp.einsum('bhncd,nbhde->bhnce', q_dec, s_prev)
    o = rms_norm(o_intra + o_inter, norm_gain)
    o = o.transpose(0, 2, 3, 1, 4).reshape(B, S, D_REC)
    return (o * jax.nn.silu(g.astype(f32))).astype(out_dtype)


def hier_moe(h, w_rg, b_rg, w_re, b_re, w_gate, w_up, w_down):
    B, S, D = h.shape
    T = B * S
    dt = h.dtype
    ht = h.reshape(T, D)
    f32 = jnp.float32
    group_p = jax.nn.softmax((ht @ w_rg).astype(f32) + b_rg.astype(f32), axis=-1)
    g_prob, g_idx = lax.top_k(group_p, 1)
    e_logit = ((ht @ w_re).astype(f32) + b_re.astype(f32)).reshape(T, N_GROUPS, EXPERTS_PER_GROUP)
    e_logit = jnp.take_along_axis(e_logit, g_idx[:, :, None], axis=1)[:, 0]
    e_p = jax.nn.softmax(e_logit, axis=-1)
    e_prob, e_local = lax.top_k(e_p, TOP_K)
    e_prob = e_prob / jnp.sum(e_prob, axis=-1, keepdims=True)
    weights = (g_prob * e_prob).reshape(-1)
    expert_ids = (g_idx * EXPERTS_PER_GROUP + e_local).reshape(-1)
    A = T * TOP_K
    token_ids = jnp.arange(A) // TOP_K

    order = jnp.argsort(expert_ids)
    sorted_e = expert_ids[order]
    sorted_tok = token_ids[order]
    counts = jnp.bincount(expert_ids, length=N_EXPERTS)
    padded = (counts + EXPERT_BLOCK - 1) // EXPERT_BLOCK * EXPERT_BLOCK
    pad_end = jnp.cumsum(padded)
    pad_start = pad_end - padded
    start = jnp.cumsum(counts) - counts
    dest = pad_start[sorted_e] + (jnp.arange(A) - start[sorted_e])
    n_rows = -(-A // EXPERT_BLOCK) * EXPERT_BLOCK + N_EXPERTS * EXPERT_BLOCK
    n_blocks = n_rows // EXPERT_BLOCK
    x_pad = jnp.zeros((n_rows, D), dt).at[dest].set(ht[sorted_tok])
    block_start = jnp.arange(n_blocks) * EXPERT_BLOCK
    block_expert = jnp.minimum(jnp.sum(block_start[:, None] >= pad_end[None, :], axis=1), N_EXPERTS - 1)

    def expert_block(args):
        xb, e = args
        hb = jax.nn.silu(xb @ w_gate[e]) * (xb @ w_up[e])
        return hb @ w_down[e]

    y_pad = lax.map(expert_block, (x_pad.reshape(n_blocks, EXPERT_BLOCK, D), block_expert))
    y_sorted = y_pad.reshape(n_rows, D)[dest] * weights[order][:, None].astype(dt)
    out = jnp.zeros((T, D), dt).at[sorted_tok].add(y_sorted)
    return out.reshape(B, S, D)


def setup_inputs(seed: int = 0) -> dict:
    key = jax.random.key(seed)
    ks = jax.random.split(key, 24)
    nrm = jax.random.normal
    f32 = jnp.float32
    L, D = DEPTH, D_MODEL
    return {
        "x": nrm(ks[0], (BATCH, SEQ, D), f32),
        "c": nrm(ks[1], (BATCH, D), f32),
        "w_ada": nrm(ks[2], (L, D, 6 * D), f32) * (0.5 * D ** -0.5),
        "b_ada": nrm(ks[3], (L, 6 * D), f32) * 0.01,
        "g_pre_mix": 1.0 + 0.01 * nrm(ks[4], (L, D), f32),
        "g_post_mix": 1.0 + 0.01 * nrm(ks[5], (L, D), f32),
        "w_in": nrm(ks[6], (L, D, D_IN), f32) * D ** -0.5,
        "dw_kernel": nrm(ks[7], (L, CONV_WIDTH, D_CONV), f32) * CONV_WIDTH ** -0.5,
        "dw_bias": nrm(ks[8], (L, D_CONV), f32) * 0.01,
        "conv_ln_gain": 1.0 + 0.01 * nrm(ks[9], (L, D_CONV), f32),
        "conv_ln_bias": nrm(ks[10], (L, D_CONV), f32) * 0.01,
        "lb_logits": nrm(ks[11], (L + 1, D_REC), f32) * 0.1,
        "rec_norm_gain": 1.0 + 0.01 * nrm(ks[12], (L, REC_DV), f32),
        "w_out": nrm(ks[13], (L, D_MIX, D), f32) * D_MIX ** -0.5,
        "g_pre_ffn": 1.0 + 0.01 * nrm(ks[14], (L, D), f32),
        "g_post_ffn": 1.0 + 0.01 * nrm(ks[15], (L, D), f32),
        "w_router_group": nrm(ks[16], (L, D, N_GROUPS), f32) * D ** -0.5,
        "b_router_group": nrm(ks[17], (L, N_GROUPS), f32) * 0.01,
        "w_router_expert": nrm(ks[18], (L, D, N_EXPERTS), f32) * D ** -0.5,
        "b_router_expert": nrm(ks[19], (L, N_EXPERTS), f32) * 0.01,
        "w_gate": nrm(ks[20], (L, N_EXPERTS, D, D_EXPERT), f32) * D ** -0.5,
        "w_up": nrm(ks[21], (L, N_EXPERTS, D, D_EXPERT), f32) * D ** -0.5,
        "w_down": nrm(ks[22], (L, N_EXPERTS, D_EXPERT, D), f32) * D_EXPERT ** -0.5,
    }


def reference(x, c, w_ada, b_ada, g_pre_mix, g_post_mix, w_in, dw_kernel, dw_bias,
              conv_ln_gain, conv_ln_bias, lb_logits, rec_norm_gain, w_out, g_pre_ffn,
              g_post_ffn, w_router_group, b_router_group, w_router_expert, b_router_expert,
              w_gate, w_up, w_down):
    cond = jax.nn.silu(c)
    lb_table = jnp.cumsum(jax.nn.softmax(lb_logits.astype(jnp.float32), axis=0), axis=0)
    for l in range(DEPTH):
        mod = (cond @ w_ada[l] + b_ada[l])[:, None, :]
        sh1, sc1, gt1, sh2, sc2, gt2 = jnp.split(mod, 6, axis=-1)

        h = rms_norm(x, g_pre_mix[l]) * (1.0 + sc1) + sh1
        proj = h @ w_in[l]
        cv, cg, q, f, i, g = jnp.split(proj, IN_SPLITS, axis=-1)
        y_conv = conv_module(cv, cg, dw_kernel[l], dw_bias[l], conv_ln_gain[l], conv_ln_bias[l])
        y_rec = hgrn2(q, f, i, g, lb_table[l], rec_norm_gain[l])
        y = jnp.concatenate([y_conv, y_rec], axis=-1) @ w_out[l]
        x = x + gt1 * rms_norm(y, g_post_mix[l])

        h = rms_norm(x, g_pre_ffn[l]) * (1.0 + sc2) + sh2
        y = hier_moe(h, w_router_group[l], b_router_group[l], w_router_expert[l],
                     b_router_expert[l], w_gate[l], w_up[l], w_down[l])
        x = x + gt2 * rms_norm(y, g_post_ffn[l])
    return x
```

```cpp
#include <hip/hip_runtime.h>
#include <cstdio>
#include <cstdint>

typedef unsigned short bf16;
#define DI __device__ __forceinline__

constexpr int D = 1024, BATCH = 8, SEQ = 4096, M = BATCH * SEQ;
constexpr int DCONV = 512, DREC = 512, NHEAD = 4, DK = 128, DV = 128, CHUNK = 64, NCHUNK = M / CHUNK;
constexpr int DIN = 3072, CW = 31;
constexpr int NGRP = 4, EPG = 8, NEXP = 32, DEXP = 256;
constexpr float EPS = 1e-6f;
constexpr int LISTCAP = 32768;
constexpr int SLOTS = 2 * M + NEXP * 256;

constexpr size_t MiB = 1u << 20;
constexpr size_t WS_CTL = 0;
constexpr size_t WS_MOD = 1 * MiB;
constexpr size_t WS_LB = WS_MOD + 256 * 1024;
constexpr size_t WS_WIN = 2 * MiB;
constexpr size_t WS_WOUT = 8 * MiB;
constexpr size_t WS_WGU = 10 * MiB;
constexpr size_t WS_WD = 42 * MiB;
constexpr size_t WS_TOKE = 58 * MiB;
constexpr size_t WS_TOKW = WS_TOKE + 256 * 1024;
constexpr size_t WS_TOKP = WS_TOKW + 256 * 1024;
constexpr size_t WS_LIST = 60 * MiB;
constexpr size_t WS_LSEG = 64 * MiB;
constexpr size_t WS_ASEG = 80 * MiB;
constexpr size_t WS_DEC = 81 * MiB;
constexpr size_t WS_XB = 82 * MiB;
constexpr size_t WS_A = 84 * MiB;
constexpr size_t WS_B = 148 * MiB;
constexpr size_t WS_U = WS_B, WS_QD = WS_B + 32 * MiB, WS_KI = WS_B + 64 * MiB, WS_KE = WS_B + 96 * MiB, WS_V = WS_B + 128 * MiB, WS_GS = WS_B + 160 * MiB;
constexpr size_t WS_HB = WS_B;
constexpr size_t WS_YB = WS_B + 36 * MiB;
constexpr size_t WS_C = 340 * MiB;
constexpr size_t WS_S = 404 * MiB;
constexpr size_t WS_END = 512 * MiB;

DI float bf2f(bf16 v) { return __uint_as_float((unsigned)v << 16); }
DI bf16 f2bf(float f) { unsigned u = __float_as_uint(f); return (bf16)((u + 0x7fffu + ((u >> 16) & 1u)) >> 16); }
DI float sigmoidf_(float x) { return 1.f / (1.f + __expf(-x)); }
DI float siluf_(float x) { return x / (1.f + __expf(-x)); }

__host__ __device__ inline int win_src_col(int n) {
    const int pn = n >> 8, half = (n >> 7) & 1, ch = n & 127;
    if (pn < 4) return (half ? 512 : 0) + 128 * pn + ch;
    if (pn < 8) return 1024 + (half ? 512 : 0) + 128 * (pn - 4) + ch;
    return 2048 + (half ? 512 : 0) + 128 * (pn - 8) + ch;
}

namespace nv {
__global__ void k_mod(const float* c, const float* w_ada, const float* b_ada, float* mod) {
    const int j = blockIdx.x * blockDim.x + threadIdx.x; if (j >= 6 * D) return;
    float acc[BATCH];
#pragma unroll
    for (int b = 0; b < BATCH; ++b) acc[b] = 0.f;
    for (int k = 0; k < D; ++k) { const float w = w_ada[(size_t)k * 6 * D + j];
#pragma unroll
        for (int b = 0; b < BATCH; ++b) acc[b] += siluf_(c[b * D + k]) * w; }
#pragma unroll
    for (int b = 0; b < BATCH; ++b) mod[b * 6 * D + j] = acc[b] + b_ada[j];
}
__global__ void k_lb(const float* lb_logits, float* lb) {
    const int j = blockIdx.x * blockDim.x + threadIdx.x; if (j >= DREC) return;
    const float a = lb_logits[j], b = lb_logits[DREC + j], m = fmaxf(a, b);
    const float ea = __expf(a - m), eb = __expf(b - m); lb[j] = ea / (ea + eb);
}
__global__ void k_wconv(const float* w_in, const float* w_out, const float* w_gate, const float* w_up, const float* w_down, bf16* WIN, bf16* WOUT, bf16* WGU, bf16* WD) {
    const size_t NT = (size_t)DIN * D + (size_t)D * D + (size_t)NEXP * 512 * D + (size_t)NEXP * D * DEXP;
    for (size_t i = (size_t)blockIdx.x * blockDim.x + threadIdx.x; i < NT; i += (size_t)gridDim.x * blockDim.x) {
        size_t r = i;
        if (r < (size_t)DIN * D) { const int n = r / D, k = r % D; WIN[r] = f2bf(w_in[(size_t)k * DIN + win_src_col(n)]); continue; } r -= (size_t)DIN * D;
        if (r < (size_t)D * D) { const int n = r / D, k = r % D; WOUT[r] = f2bf(w_out[(size_t)k * D + n]); continue; } r -= (size_t)D * D;
        if (r < (size_t)NEXP * 512 * D) { const int e = r / (512 * D), n = (r / D) % 512, k = r % D; const int pn = n >> 8, half = (n >> 7) & 1, ch = 128 * pn + (n & 127);
            const float* src = half ? w_up : w_gate; WGU[r] = f2bf(src[((size_t)e * D + k) * DEXP + ch]); continue; } r -= (size_t)NEXP * 512 * D;
        { const int e = r / (D * DEXP), n = (r / DEXP) % D, k = r % DEXP; WD[r] = f2bf(w_down[((size_t)e * DEXP + k) * D + n]); }
    }
}
__global__ void k_h1(const float* x, const float* g, const float* mod, bf16* H1) {
    const int row = blockIdx.x, b = row / SEQ, t = threadIdx.x;
    __shared__ float red[256];
    float v[4], s = 0.f; for (int i = 0; i < 4; ++i) { v[i] = x[(size_t)row * D + t + 256 * i]; s += v[i] * v[i]; }
    red[t] = s; __syncthreads(); for (int o = 128; o > 0; o >>= 1) { if (t < o) red[t] += red[t + o]; __syncthreads(); }
    const float rstd = rsqrtf(red[0] / D + EPS);
    const float* sh = mod + b * 6 * D, *sc = sh + D;
    for (int i = 0; i < 4; ++i) { const int c = t + 256 * i; H1[(size_t)row * D + c] = f2bf(v[i] * rstd * g[c] * (1.f + sc[c]) + sh[c]); }
}
struct EpiF32Store { float* C; int ldc; int pad; DI void operator()(int m, int n, float v) const { C[(size_t)m * ldc + n] = v; } };
struct EpiBf16Store { bf16* C; int ldc; int pad; DI void operator()(int m, int n, float v) const { C[(size_t)m * ldc + n] = f2bf(v); } };
template <class Epi>
__global__ void k_gemm(const bf16* A, int lda, const int* rowidx, const bf16* Bt, int Mrows, int N, int K, Epi epi) {
    __shared__ float As[16][65], Bs[16][65];
    const int tx = threadIdx.x & 15, ty = threadIdx.x >> 4, m0 = blockIdx.y * 64, n0 = blockIdx.x * 64;
    float acc[4][4]; for (int i = 0; i < 4; ++i) for (int j = 0; j < 4; ++j) acc[i][j] = 0.f;
    for (int k0 = 0; k0 < K; k0 += 16) {
        for (int i = 0; i < 4; ++i) { const int idx = threadIdx.x + i * 256, r = idx >> 4, c = idx & 15, gm = m0 + r; float v = 0.f;
            if (gm < Mrows) { const int src = rowidx ? rowidx[gm] : gm; v = bf2f(A[(size_t)src * lda + k0 + c]); } As[c][r] = v;
            Bs[c][r] = bf2f(Bt[(size_t)(n0 + r) * K + k0 + c]); }
        __syncthreads();
        for (int kk = 0; kk < 16; ++kk) { float a[4], b[4]; for (int i = 0; i < 4; ++i) { a[i] = As[kk][ty * 4 + i]; b[i] = Bs[kk][tx * 4 + i]; }
            for (int i = 0; i < 4; ++i) for (int j = 0; j < 4; ++j) acc[i][j] += a[i] * b[j]; }
        __syncthreads();
    }
    for (int i = 0; i < 4; ++i) for (int j = 0; j < 4; ++j) { const int gm = m0 + ty * 4 + i, gn = n0 + tx * 4 + j; if (gm < Mrows) epi(gm, gn, acc[i][j]); }
}
struct Seg { int base[NEXP + 1]; };
DI void seg_bases(const int* cnt, int e, int& base, int& n) { int b = 0; for (int i = 0; i < e; ++i) b += (cnt[i] + 255) / 256 * 256; base = b; n = cnt[e]; }
__global__ void k_gemm_e1(const bf16* H2, const int* list, const int* cnt, const bf16* WGU, float* GU) {
    const int e = blockIdx.z; int base, n; seg_bases(cnt, e, base, n);
    const int m0 = blockIdx.y * 64; if (m0 >= n) return;
    __shared__ float As[16][65], Bs[16][65];
    const int tx = threadIdx.x & 15, ty = threadIdx.x >> 4, n0 = blockIdx.x * 64; const bf16* Bt = WGU + (size_t)e * 512 * D;
    float acc[4][4]; for (int i = 0; i < 4; ++i) for (int j = 0; j < 4; ++j) acc[i][j] = 0.f;
    for (int k0 = 0; k0 < D; k0 += 16) {
        for (int i = 0; i < 4; ++i) { const int idx = threadIdx.x + i * 256, r = idx >> 4, c = idx & 15, gm = m0 + r; float v = 0.f;
            if (gm < n) { const int tok = list[e * LISTCAP + gm] >> 1; v = bf2f(H2[(size_t)tok * D + k0 + c]); } As[c][r] = v;
            Bs[c][r] = bf2f(Bt[(size_t)(n0 + r) * D + k0 + c]); }
        __syncthreads();
        for (int kk = 0; kk < 16; ++kk) { float a[4], b[4]; for (int i = 0; i < 4; ++i) { a[i] = As[kk][ty * 4 + i]; b[i] = Bs[kk][tx * 4 + i]; }
            for (int i = 0; i < 4; ++i) for (int j = 0; j < 4; ++j) acc[i][j] += a[i] * b[j]; }
        __syncthreads();
    }
    for (int i = 0; i < 4; ++i) for (int j = 0; j < 4; ++j) { const int gm = m0 + ty * 4 + i, gn = n0 + tx * 4 + j; if (gm < n) GU[(size_t)(base + gm) * 512 + gn] = acc[i][j]; }
}
__global__ void k_hb(const float* GU, const int* cnt, bf16* HB) {
    int total = 0; for (int i = 0; i < NEXP; ++i) total += (cnt[i] + 255) / 256 * 256;
    for (size_t i = (size_t)blockIdx.x * blockDim.x + threadIdx.x; i < (size_t)total * 256; i += (size_t)gridDim.x * blockDim.x) {
        const size_t s = i / 256; const int h = i % 256, pn = h >> 7, ch = h & 127;
        const float g = GU[s * 512 + 256 * pn + ch], u = GU[s * 512 + 256 * pn + 128 + ch]; HB[s * 256 + h] = f2bf(siluf_(g) * u); }
}
__global__ void k_gemm_e2(const bf16* HB, const int* cnt, const bf16* WD, bf16* YB) {
    const int e = blockIdx.z; int base, n; seg_bases(cnt, e, base, n);
    const int m0 = blockIdx.y * 64; if (m0 >= n) return;
    __shared__ float As[16][65], Bs[16][65];
    const int tx = threadIdx.x & 15, ty = threadIdx.x >> 4, n0 = blockIdx.x * 64; const bf16* Bt = WD + (size_t)e * D * DEXP;
    float acc[4][4]; for (int i = 0; i < 4; ++i) for (int j = 0; j < 4; ++j) acc[i][j] = 0.f;
    for (int k0 = 0; k0 < DEXP; k0 += 16) {
        for (int i = 0; i < 4; ++i) { const int idx = threadIdx.x + i * 256, r = idx >> 4, c = idx & 15, gm = m0 + r; float v = 0.f;
            if (gm < n) v = bf2f(HB[(size_t)(base + gm) * DEXP + k0 + c]); As[c][r] = v;
            Bs[c][r] = bf2f(Bt[(size_t)(n0 + r) * DEXP + k0 + c]); }
        __syncthreads();
        for (int kk = 0; kk < 16; ++kk) { float a[4], b[4]; for (int i = 0; i < 4; ++i) { a[i] = As[kk][ty * 4 + i]; b[i] = Bs[kk][tx * 4 + i]; }
            for (int i = 0; i < 4; ++i) for (int j = 0; j < 4; ++j) acc[i][j] += a[i] * b[j]; }
        __syncthreads();
    }
    for (int i = 0; i < 4; ++i) for (int j = 0; j < 4; ++j) { const int gm = m0 + ty * 4 + i, gn = n0 + tx * 4 + j; if (gm < n) YB[(size_t)(base + gm) * D + gn] = f2bf(acc[i][j]); }
}
__global__ void k_p2epi(const float* PROJ, int row0, int nrows, const float* lb, bf16* U, bf16* QD, bf16* KI, bf16* KE, bf16* V, bf16* GS, float* DEC) {
    const int nchunks = nrows / CHUNK; const int total = nchunks * 3 * 4 * 128;
    const int id = blockIdx.x * blockDim.x + threadIdx.x; if (id >= total) return;
    const int ch = id & 127, j = (id >> 7) & 3, kind = (id >> 9) % 3, chunk = id / (512 * 3);
    const int colA = 256 * (4 * kind + j) + ch, colB = colA + 128, oc = 128 * j + ch;
    const size_t lr0 = (size_t)chunk * CHUNK;
    if (kind == 0) { for (int r = 0; r < CHUNK; ++r) { const float a = PROJ[(lr0 + r) * DIN + colA], g = PROJ[(lr0 + r) * DIN + colB]; U[(size_t)(row0 + lr0 + r) * 512 + oc] = f2bf(a * sigmoidf_(g)); } }
    else if (kind == 2) { for (int r = 0; r < CHUNK; ++r) { const float a = PROJ[(lr0 + r) * DIN + colA], g = PROJ[(lr0 + r) * DIN + colB]; V[(size_t)(row0 + lr0 + r) * 512 + oc] = f2bf(a); GS[(size_t)(row0 + lr0 + r) * 512 + oc] = f2bf(siluf_(g)); } }
    else {
        const float l = lb[oc]; float b = 0.f, bl = 0.f;
        for (int r = 0; r < CHUNK; ++r) { const float f = PROJ[(lr0 + r) * DIN + colB]; const float k = (1.f - l) * sigmoidf_(-f); bl += logf(1.f - k); }
        for (int r = 0; r < CHUNK; ++r) { const float q = PROJ[(lr0 + r) * DIN + colA], f = PROJ[(lr0 + r) * DIN + colB]; const float k = (1.f - l) * sigmoidf_(-f); b += logf(1.f - k);
            const size_t o = (size_t)(row0 + lr0 + r) * 512 + oc; QD[o] = f2bf(siluf_(q) * __expf(b)); KI[o] = f2bf(k * __expf(-b)); KE[o] = f2bf(k * __expf(bl - b)); }
        DEC[(size_t)((row0 + lr0) / CHUNK) * 512 + oc] = __expf(bl);
    }
}
__global__ void k_conv(const bf16* U, const float* dw, const float* dwb, const float* lng, const float* lnb, bf16* YCAT) {
    const int row = blockIdx.x, t = row % SEQ, c0 = threadIdx.x;
    __shared__ float red[256];
    float v[2];
    for (int i = 0; i < 2; ++i) { const int c = c0 + 256 * i; float a = dwb[c];
        for (int j = 0; j < CW; ++j) { const int tt = t - (CW - 1) + j; if (tt >= 0) a += dw[j * DCONV + c] * bf2f(U[(size_t)(row - (CW - 1) + j) * 512 + c]); } v[i] = a; }
    red[c0] = v[0] + v[1]; __syncthreads(); for (int o = 128; o > 0; o >>= 1) { if (c0 < o) red[c0] += red[c0 + o]; __syncthreads(); }
    const float mu = red[0] / DCONV; __syncthreads();
    red[c0] = (v[0] - mu) * (v[0] - mu) + (v[1] - mu) * (v[1] - mu); __syncthreads(); for (int o = 128; o > 0; o >>= 1) { if (c0 < o) red[c0] += red[c0 + o]; __syncthreads(); }
    const float rstd = rsqrtf(red[0] / DCONV + EPS);
    for (int i = 0; i < 2; ++i) { const int c = c0 + 256 * i; const float y = (v[i] - mu) * rstd * lng[c] + lnb[c]; YCAT[(size_t)row * D + c] = f2bf(siluf_(y)); }
}
__global__ void __launch_bounds__(128) k_hgrn2(const bf16* QD, const bf16* KI, const bf16* KE, const bf16* V, const bf16* GS, const float* DEC, const float* ng, bf16* YCAT) {
    const int b = blockIdx.x / NHEAD, h = blockIdx.x % NHEAD, dv = threadIdx.x;
    __shared__ bf16 sq[CHUNK][DK], sk[CHUNK][DK + 2]; __shared__ float sc[CHUNK][CHUNK + 1], red[4];
    float S[DK];
#pragma unroll
    for (int i = 0; i < DK; ++i) S[i] = 0.f;
    for (int n = 0; n < SEQ / CHUNK; ++n) {
        const size_t r0 = (size_t)b * SEQ + (size_t)n * CHUNK;
        for (int i = threadIdx.x; i < CHUNK * DK; i += 128) { const int r = i / DK, d = i % DK; sq[r][d] = QD[(r0 + r) * 512 + h * DK + d]; sk[r][d] = KI[(r0 + r) * 512 + h * DK + d]; }
        __syncthreads();
        for (int i = threadIdx.x; i < CHUNK * CHUNK; i += 128) { const int c = i / CHUNK, s = i % CHUNK; float a = 0.f; if (s <= c) for (int d = 0; d < DK; ++d) a += bf2f(sq[c][d]) * bf2f(sk[s][d]); sc[c][s] = a; }
        __syncthreads();
        for (int c = 0; c < CHUNK; ++c) {
            float o = 0.f;
#pragma unroll
            for (int d = 0; d < DK; ++d) o += bf2f(sq[c][d]) * S[d];
            for (int s = 0; s <= c; ++s) o += sc[c][s] * bf2f(V[(r0 + s) * 512 + h * DV + dv]);
            float ss = o * o; for (int off = 32; off > 0; off >>= 1) ss += __shfl_xor(ss, off);
            __syncthreads(); if ((threadIdx.x & 63) == 0) red[threadIdx.x >> 6] = ss; __syncthreads();
            const float rstd = rsqrtf((red[0] + red[1]) / DV + EPS);
            const float g = bf2f(GS[(r0 + c) * 512 + h * DV + dv]);
            YCAT[(r0 + c) * D + 512 + h * DV + dv] = f2bf(o * rstd * ng[dv] * g);
        }
        __syncthreads();
        for (int i = threadIdx.x; i < CHUNK * DK; i += 128) { const int r = i / DK, d = i % DK; sk[r][d] = KE[(r0 + r) * 512 + h * DK + d]; }
        __syncthreads();
        const float* dec = DEC + (size_t)(r0 / CHUNK) * 512 + h * DK;
#pragma unroll
        for (int d = 0; d < DK; ++d) S[d] *= dec[d];
        for (int s = 0; s < CHUNK; ++s) { const float v = bf2f(V[(r0 + s) * 512 + h * DV + dv]);
#pragma unroll
            for (int d = 0; d < DK; ++d) S[d] += bf2f(sk[s][d]) * v; }
        __syncthreads();
    }
}
__global__ void k_post_mix(const float* Y2, int row0, const float* x, const float* gpost, const float* gpre, const float* mod, float* X1, bf16* H2) {
    const int lrow = blockIdx.x, row = row0 + lrow, b = row / SEQ, t = threadIdx.x;
    __shared__ float red[256];
    float y[4], s = 0.f; for (int i = 0; i < 4; ++i) { y[i] = Y2[(size_t)lrow * D + t + 256 * i]; s += y[i] * y[i]; }
    red[t] = s; __syncthreads(); for (int o = 128; o > 0; o >>= 1) { if (t < o) red[t] += red[t + o]; __syncthreads(); }
    const float rstd = rsqrtf(red[0] / D + EPS); __syncthreads();
    const float* mb = mod + b * 6 * D;
    float x1[4]; s = 0.f; for (int i = 0; i < 4; ++i) { const int c = t + 256 * i; x1[i] = x[(size_t)row * D + c] + mb[2 * D + c] * (y[i] * rstd * gpost[c]); s += x1[i] * x1[i]; X1[(size_t)row * D + c] = x1[i]; }
    red[t] = s; __syncthreads(); for (int o = 128; o > 0; o >>= 1) { if (t < o) red[t] += red[t + o]; __syncthreads(); }
    const float rstd2 = rsqrtf(red[0] / D + EPS);
    for (int i = 0; i < 4; ++i) { const int c = t + 256 * i; H2[(size_t)row * D + c] = f2bf(x1[i] * rstd2 * gpre[c] * (1.f + mb[4 * D + c]) + mb[3 * D + c]); }
}
__global__ void k_router(const bf16* H2, const float* wrg, const float* brg, const float* wre, const float* bre, int* TOKE, float* TOKW, int* TOKP, int* cnt, int* list) {
    const int tok = blockIdx.x * 4 + (threadIdx.x >> 6), lane = threadIdx.x & 63;
    float acc[36];
#pragma unroll
    for (int i = 0; i < 36; ++i) acc[i] = 0.f;
    for (int k = lane; k < D; k += 64) { const float h = bf2f(H2[(size_t)tok * D + k]);
#pragma unroll
        for (int i = 0; i < 4; ++i) acc[i] += h * wrg[k * 4 + i];
#pragma unroll
        for (int i = 0; i < 32; ++i) acc[4 + i] += h * wre[k * 32 + i]; }
#pragma unroll
    for (int i = 0; i < 36; ++i) for (int off = 32; off > 0; off >>= 1) acc[i] += __shfl_xor(acc[i], off);
    if (lane == 0) {
        float gv = -1e30f; int gi = 0;
#pragma unroll
        for (int i = 0; i < 4; ++i) { acc[i] += brg[i]; if (acc[i] > gv) { gv = acc[i]; gi = i; } }
        float se = 0.f;
#pragma unroll
        for (int i = 0; i < 4; ++i) se += __expf(acc[i] - gv);
        const float gp = 1.f / se;
        float el[8];
#pragma unroll
        for (int i = 0; i < 8; ++i) el[i] = 0.f;
#pragma unroll
        for (int g = 0; g < 4; ++g)
#pragma unroll
            for (int i = 0; i < 8; ++i) if (g == gi) el[i] = acc[4 + 8 * g + i] + bre[8 * g + i];
        float v0 = -1e30f, v1 = -1e30f; int i0 = 0, i1 = 0;
#pragma unroll
        for (int i = 0; i < 8; ++i) { if (el[i] > v0) { v1 = v0; i1 = i0; v0 = el[i]; i0 = i; } else if (el[i] > v1) { v1 = el[i]; i1 = i; } }
        const float p1 = __expf(v1 - v0), ps = 1.f + p1;
        const int e0 = gi * 8 + i0, e1 = gi * 8 + i1;
        TOKE[tok * 2] = e0; TOKE[tok * 2 + 1] = e1; TOKW[tok * 2] = gp / ps; TOKW[tok * 2 + 1] = gp * p1 / ps;
        const int q0 = atomicAdd(&cnt[e0], 1), q1 = atomicAdd(&cnt[e1], 1);
        TOKP[tok * 2] = q0; TOKP[tok * 2 + 1] = q1; list[e0 * LISTCAP + q0] = tok * 2; list[e1 * LISTCAP + q1] = tok * 2 + 1;
    }
}
__global__ void k_final(const bf16* YB, const int* TOKE, const float* TOKW, const int* TOKP, const int* cnt, const float* gpost, const float* mod, float* out) {
    const int row = blockIdx.x, b = row / SEQ, t = threadIdx.x;
    __shared__ float red[256];
    int base0, base1, n; seg_bases(cnt, TOKE[row * 2], base0, n); seg_bases(cnt, TOKE[row * 2 + 1], base1, n);
    const size_t s0 = base0 + TOKP[row * 2], s1 = base1 + TOKP[row * 2 + 1]; const float w0 = TOKW[row * 2], w1 = TOKW[row * 2 + 1];
    float y[4], s = 0.f; for (int i = 0; i < 4; ++i) { const int c = t + 256 * i; y[i] = w0 * bf2f(YB[s0 * D + c]) + w1 * bf2f(YB[s1 * D + c]); s += y[i] * y[i]; }
    red[t] = s; __syncthreads(); for (int o = 128; o > 0; o >>= 1) { if (t < o) red[t] += red[t + o]; __syncthreads(); }
    const float rstd = rsqrtf(red[0] / D + EPS); const float* gt2 = mod + b * 6 * D + 5 * D;
    for (int i = 0; i < 4; ++i) { const int c = t + 256 * i; out[(size_t)row * D + c] += gt2[c] * (y[i] * rstd * gpost[c]); }
}
}

extern "C" void kernel_launch(void* const* d_in, const int* in_sizes, int n_in, void* d_out, int out_size, void* d_ws, size_t ws_size, hipStream_t stream) {
    if (n_in != 23 || out_size != M * D || ws_size < WS_END) { fprintf(stderr, "kernel_launch: unexpected shapes n_in %d out %d ws %zu\n", n_in, out_size, ws_size); return; }
    const float* x = (const float*)d_in[0]; const float* c = (const float*)d_in[1]; const float* w_ada = (const float*)d_in[2]; const float* b_ada = (const float*)d_in[3];
    const float* g_pre_mix = (const float*)d_in[4]; const float* g_post_mix = (const float*)d_in[5]; const float* w_in = (const float*)d_in[6];
    const float* dw_kernel = (const float*)d_in[7]; const float* dw_bias = (const float*)d_in[8]; const float* ln_g = (const float*)d_in[9]; const float* ln_b = (const float*)d_in[10];
    const float* lb_logits = (const float*)d_in[11]; const float* rec_ng = (const float*)d_in[12]; const float* w_out = (const float*)d_in[13];
    const float* g_pre_ffn = (const float*)d_in[14]; const float* g_post_ffn = (const float*)d_in[15];
    const float* w_rg = (const float*)d_in[16]; const float* b_rg = (const float*)d_in[17]; const float* w_re = (const float*)d_in[18]; const float* b_re = (const float*)d_in[19];
    const float* w_gate = (const float*)d_in[20]; const float* w_up = (const float*)d_in[21]; const float* w_down = (const float*)d_in[22];
    char* ws = (char*)d_ws; float* out = (float*)d_out;
    int* CNT = (int*)(ws + WS_CTL); float* MOD = (float*)(ws + WS_MOD); float* LB = (float*)(ws + WS_LB);
    bf16 *WIN = (bf16*)(ws + WS_WIN), *WOUT = (bf16*)(ws + WS_WOUT), *WGU = (bf16*)(ws + WS_WGU), *WD = (bf16*)(ws + WS_WD);
    int* TOKE = (int*)(ws + WS_TOKE); float* TOKW = (float*)(ws + WS_TOKW); int* TOKP = (int*)(ws + WS_TOKP); int* LIST = (int*)(ws + WS_LIST);
    float* DEC = (float*)(ws + WS_DEC);
    bf16 *HA = (bf16*)(ws + WS_A), *U = (bf16*)(ws + WS_U), *QD = (bf16*)(ws + WS_QD), *KI = (bf16*)(ws + WS_KI), *KE = (bf16*)(ws + WS_KE), *V = (bf16*)(ws + WS_V), *GS = (bf16*)(ws + WS_GS);
    bf16 *HB = (bf16*)(ws + WS_HB), *YB = (bf16*)(ws + WS_YB), *YCAT = (bf16*)(ws + WS_C);
    float* SCR = (float*)(ws + WS_S);

    (void)hipMemsetAsync(ws + WS_CTL, 0, 1 * MiB, stream);
    nv::k_mod<<<6 * D / 256, 256, 0, stream>>>(c, w_ada, b_ada, MOD);
    nv::k_lb<<<2, 256, 0, stream>>>(lb_logits, LB);
    nv::k_wconv<<<4096, 256, 0, stream>>>(w_in, w_out, w_gate, w_up, w_down, WIN, WOUT, WGU, WD);
    nv::k_h1<<<M, 256, 0, stream>>>(x, g_pre_mix, MOD, HA);
    constexpr int RC = 8192;
    for (int r0 = 0; r0 < M; r0 += RC) {
        nv::k_gemm<nv::EpiF32Store><<<dim3(DIN / 64, RC / 64), 256, 0, stream>>>(HA + (size_t)r0 * D, D, nullptr, WIN, RC, DIN, D, nv::EpiF32Store{SCR, DIN, 0});
        nv::k_p2epi<<<(RC / CHUNK) * 3 * 4 * 128 / 256, 256, 0, stream>>>(SCR, r0, RC, LB, U, QD, KI, KE, V, GS, DEC);
    }
    nv::k_conv<<<M, 256, 0, stream>>>(U, dw_kernel, dw_bias, ln_g, ln_b, YCAT);
    nv::k_hgrn2<<<BATCH * NHEAD, 128, 0, stream>>>(QD, KI, KE, V, GS, DEC, rec_ng, YCAT);
    for (int r0 = 0; r0 < M; r0 += RC) {
        nv::k_gemm<nv::EpiF32Store><<<dim3(D / 64, RC / 64), 256, 0, stream>>>(YCAT + (size_t)r0 * D, D, nullptr, WOUT, RC, D, D, nv::EpiF32Store{SCR, D, 0});
        nv::k_post_mix<<<RC, 256, 0, stream>>>(SCR, r0, x, g_post_mix, g_pre_ffn, MOD, out, HA);
    }
    nv::k_router<<<M / 4, 256, 0, stream>>>(HA, w_rg, b_rg, w_re, b_re, TOKE, TOKW, TOKP, CNT, LIST);
    float* GU = (float*)(ws + WS_C);
    nv::k_gemm_e1<<<dim3(512 / 64, LISTCAP / 64, NEXP), 256, 0, stream>>>(HA, LIST, CNT, WGU, GU);
    nv::k_hb<<<4096, 256, 0, stream>>>(GU, CNT, HB);
    nv::k_gemm_e2<<<dim3(D / 64, LISTCAP / 64, NEXP), 256, 0, stream>>>(HB, CNT, WD, YB);
    nv::k_final<<<M, 256, 0, stream>>>(YB, TOKE, TOKW, TOKP, CNT, g_post_ffn, MOD, out);
}
```

```cpp
#include <hip/hip_runtime.h>
#include <cstdio>
#include <cstdint>

typedef unsigned short bf16;
#define DI __device__ __forceinline__

constexpr int D = 1024, BATCH = 8, SEQ = 4096, M = BATCH * SEQ;
constexpr int DCONV = 512, DREC = 512, NHEAD = 4, DK = 128, DV = 128, CHUNK = 64, NCHUNK = M / CHUNK;
constexpr int DIN = 3072, CW = 31;
constexpr int NGRP = 4, EPG = 8, NEXP = 32, DEXP = 256;
constexpr float EPS = 1e-6f;
constexpr int LISTCAP = 32768;
constexpr int SLOTS = 2 * M + NEXP * 256;

constexpr size_t MiB = 1u << 20;
constexpr size_t WS_CTL = 0;
constexpr size_t WS_MOD = 1 * MiB;
constexpr size_t WS_LB = WS_MOD + 256 * 1024;
constexpr size_t WS_CV = WS_MOD + 512 * 1024;
constexpr size_t WS_WR = WS_MOD + 768 * 1024;
constexpr size_t WS_WIN = 2 * MiB;
constexpr size_t WS_WOUT = 8 * MiB;
constexpr size_t WS_WGU = 10 * MiB;
constexpr size_t WS_WD = 42 * MiB;
constexpr size_t WS_TOKE = 58 * MiB;
constexpr size_t WS_TOKW = WS_TOKE + 256 * 1024;
constexpr size_t WS_TOKP = WS_TOKW + 256 * 1024;
constexpr size_t WS_LIST = 60 * MiB;
constexpr size_t WS_LSEG = 64 * MiB;
constexpr size_t WS_ASEG = 80 * MiB;
constexpr size_t WS_DEC = 81 * MiB;
constexpr size_t WS_XB = 82 * MiB;
constexpr size_t WS_A = 84 * MiB;
constexpr size_t WS_B = 148 * MiB;
constexpr size_t WS_U = WS_B, WS_QD = WS_B + 32 * MiB, WS_KI = WS_B + 64 * MiB, WS_KE = WS_B + 96 * MiB, WS_V = WS_B + 128 * MiB, WS_GS = WS_B + 160 * MiB;
constexpr size_t WS_Y2 = WS_B;
constexpr size_t WS_HB = WS_B;
constexpr size_t WS_YB = WS_B + 36 * MiB;
constexpr size_t WS_C = 340 * MiB;
constexpr size_t WS_S = 404 * MiB;
constexpr size_t WS_END = 512 * MiB;

DI float bf2f(bf16 v) { return __uint_as_float((unsigned)v << 16); }
DI bf16 f2bf(float f) { unsigned u = __float_as_uint(f); return (bf16)((u + 0x7fffu + ((u >> 16) & 1u)) >> 16); }
DI float sigmoidf_(float x) { return 1.f / (1.f + __expf(-x)); }
DI float siluf_(float x) { return x / (1.f + __expf(-x)); }

__host__ __device__ inline int win_src_col(int n) {
    const int pn = n >> 8, half = (n >> 7) & 1, ch = n & 127;
    if (pn < 4) return (half ? 512 : 0) + 128 * pn + ch;
    if (pn < 8) return 1024 + (half ? 512 : 0) + 128 * (pn - 4) + ch;
    return 2048 + (half ? 512 : 0) + 128 * (pn - 8) + ch;
}


namespace pg8 {
#define PG8_LAS __attribute__((address_space(3)))
typedef unsigned short bf16_t;
typedef short bf16x8 __attribute__((ext_vector_type(8)));
typedef float f32x4 __attribute__((ext_vector_type(4)));
typedef unsigned u32x4 __attribute__((ext_vector_type(4)));
constexpr int BM = 256, BK = 64, HALF = 128, HTB = HALF * BK * 2  , STAGE_BYTES = 8 * HTB, NXCD = 8, WGM = 8;

__host__ __device__ __forceinline__ int lds_byte(int r, int c) { const int st = (r >> 4) * 2 + (c >> 5), rr = r & 15, cc = c & 31, ob = rr * 64 + cc * 2; return st * 1024 + (ob ^ (((ob >> 9) & 1) << 5)); }
__host__ __device__ __forceinline__ void stage_rc(int b, int& R, int& C) { const int st = b / 1024, sb = b % 1024, swz = sb ^ (((sb >> 9) & 1) << 5); R = (st >> 1) * 16 + swz / 64; C = (st & 1) * 32 + (swz % 64) / 2; }
__host__ __device__ __forceinline__ int perm32(int rho) { const int n = rho >> 4, i = rho & 15; return 8 * (i >> 2) + 4 * n + (i & 3); }

struct Unit { int pm, pn, e, r0, ne; };
struct Gemm { const bf16_t* A; const bf16_t* Bt; int M, N, K; size_t b_estride; const int* list; int listcap; };

struct StaticOrder {
    int nM, nN, nwg, G, c;
    __host__ __device__ void init(int M, int N, int G_, int c_) { nM = M / BM; nN = N / BM; nwg = nM * nN; G = G_; c = c_; }
    __host__ __device__ bool next(int i, Unit& u) const {
        const long L = (long)i * G + c; if (L >= nwg) return false;
        int wgid = (int)L; { const int q = nwg / NXCD, r = nwg % NXCD, xcd = wgid % NXCD, off = wgid / NXCD; wgid = (xcd < r ? xcd * (q + 1) : r * (q + 1) + (xcd - r) * q) + off; }
        const int nig = WGM * nN, gid = wgid / nig, fm = gid * WGM, gsz = (nM - fm) < WGM ? (nM - fm) : WGM;
        u.pm = fm + ((wgid % nig) % gsz); u.pn = (wgid % nig) / gsz; u.e = 0; u.r0 = 0; u.ne = 0; return true;
    }
    __device__ __forceinline__ void a_ready(const Unit&) const {}
    __device__ __forceinline__ void done(const Unit&) const {}
};


__device__ __forceinline__ unsigned cvt_pk_bf16(float lo, float hi) { unsigned r; asm volatile("v_cvt_pk_bf16_f32 %0, %1, %2" : "=v"(r) : "v"(lo), "v"(hi)); return r; }
typedef float f32x2 __attribute__((ext_vector_type(2)));

template <class Epi, class Sched, bool ALIGN_EPI = false, bool SP2 = false, bool GATHER = false>
__device__ __forceinline__ void gemm_phase(PG8_LAS unsigned char* lds, const Gemm g, const Sched& S, const Epi& E) {
    const int tid = threadIdx.x, wid = __builtin_amdgcn_readfirstlane(tid >> 6), lane = tid & 63, wr = wid >> 2, wc = wid & 3, fr = lane & 15, fq = lane >> 4;
    const int K = g.K, nt = K / BK;
    unsigned voffA[2], voffB[2]; unsigned voffAg[2][2];
#pragma unroll
    for (int i = 0; i < 2; ++i) { int R, C; stage_rc(tid * 16 + i * 8192, R, C); const int Rb = Epi::PERM ? ((R & ~31) + perm32(R & 31)) : R;
        voffA[i] = (unsigned)(R * K + C) * 2u; voffB[i] = (unsigned)(Rb * K + C) * 2u; }
    const size_t kstep = (size_t)(BK * 2);
    const size_t hstep = (size_t)HALF * K * 2;
    const size_t tstep = 2 * hstep;
    const unsigned ldsw = (unsigned)wid * 1024u;
    const int aoff = lds_byte(wr * 64 + fr, fq * 8), boff = lds_byte(wc * 32 + fr, fq * 8);
#define PG8_SA(b, h) (((b) * 2 + (h)) * HTB)
#define PG8_SB(b, h) ((4 + (b) * 2 + (h)) * HTB)
#define PG8_STAGE(bufoff, gbase, voff) do { _Pragma("unroll") for (int _i = 0; _i < 2; ++_i) \
        __builtin_amdgcn_global_load_lds((const unsigned*)((const char*)(gbase) + (voff)[_i]), (PG8_LAS unsigned*)(lds + (bufoff) + ldsw + _i * 8192), 16, 0, 0); } while (0)
#define PG8_STAGE_A(bufoff, gbase, h) do { if constexpr (GATHER) { PG8_STAGE(bufoff, gbase, voffAg[h]); } else { PG8_STAGE(bufoff, (gbase) + (h) * hstep, voffA); } } while (0)
#define PG8_GLOAD(dst, un) do { _Pragma("unroll") for (int _h = 0; _h < 2; ++_h) _Pragma("unroll") for (int _i = 0; _i < 2; ++_i) { int _R, _C; stage_rc(tid * 16 + _i * 8192, _R, _C); const int _pos = (un).r0 + 128 * _h + _R; \
        int _tok = 0; if (_pos < (un).ne) _tok = g.list[(size_t)(un).e * g.listcap + _pos] >> 1; dst[_h][_i] = (unsigned)(_tok * K + _C) * 2u; } } while (0)
#define PG8_GPREFETCH(un) do { if (wid == 0) __builtin_amdgcn_global_load_lds((const unsigned*)(g.list + (size_t)(un).e * g.listcap + (un).r0 + lane * 4), (PG8_LAS unsigned*)(lds + STAGE_BYTES + 1024), 16, 0, 0); } while (0)
#define PG8_GFROMLDS(dst, un) do { _Pragma("unroll") for (int _h = 0; _h < 2; ++_h) _Pragma("unroll") for (int _i = 0; _i < 2; ++_i) { int _R, _C; stage_rc(tid * 16 + _i * 8192, _R, _C); const int _p = 128 * _h + _R; \
        int _tok = ((const PG8_LAS int*)(lds + STAGE_BYTES + 1024))[_p] >> 1; if ((un).r0 + _p >= (un).ne) _tok = 0; dst[_h][_i] = (unsigned)(_tok * K + _C) * 2u; } } while (0)
#define PG8_GSWITCH do { if constexpr (GATHER) { if (last && has_next) { PG8_GFROMLDS(voffAg, nxt); } } } while (0)
#define PG8_LDA(dst, b, h) do { _Pragma("unroll") for (int m = 0; m < 4; ++m) _Pragma("unroll") for (int k = 0; k < 2; ++k) dst[m][k] = *(const PG8_LAS bf16x8*)(lds + PG8_SA(b, h) + aoff + m * 2048 + k * 1024); } while (0)
#define PG8_LDB(dst, b, h) do { _Pragma("unroll") for (int n = 0; n < 2; ++n) _Pragma("unroll") for (int k = 0; k < 2; ++k) dst[n][k] = *(const PG8_LAS bf16x8*)(lds + PG8_SB(b, h) + boff + n * 2048 + k * 1024); } while (0)
#define PG8_MMA(ai, bj, At, Bt) do { __builtin_amdgcn_s_setprio(1); _Pragma("unroll") for (int m = 0; m < 4; ++m) _Pragma("unroll") for (int n = 0; n < 2; ++n) _Pragma("unroll") for (int k = 0; k < 2; ++k) \
        acc[ai][bj][m][n] = __builtin_amdgcn_mfma_f32_16x16x32_bf16(Bt[n][k], At[m][k], acc[ai][bj][m][n], 0, 0, 0); __builtin_amdgcn_s_setprio(0); } while (0)
#define PG8_WAIT_V(n) asm volatile("s_waitcnt vmcnt(" #n ")" ::: "memory")
#define PG8_WAIT_L(n) asm volatile("s_waitcnt lgkmcnt(" #n ")" ::: "memory")
#define PG8_BAR __builtin_amdgcn_s_barrier()
#define PG8_SCHED __builtin_amdgcn_sched_barrier(0)
    Unit cur, nxt; int ui = 0; cur.e = 0;
    if (!S.next(0, cur)) return;
    f32x4 acc[2][2][4][2];
#pragma unroll
    for (int a = 0; a < 2; ++a)
#pragma unroll
        for (int b = 0; b < 2; ++b)
#pragma unroll
            for (int m = 0; m < 4; ++m)
#pragma unroll
                for (int n = 0; n < 2; ++n) acc[a][b][m][n] = (f32x4){0.f, 0.f, 0.f, 0.f};
    bf16x8 At[4][2], B0[2][2], B1[2][2];
    const char* cA = (const char*)g.A + (GATHER ? (size_t)0 : (size_t)cur.pm * tstep); const char* cB = (const char*)g.Bt + (size_t)cur.e * g.b_estride + (size_t)cur.pn * tstep;
    if constexpr (GATHER) { PG8_GLOAD(voffAg, cur); }
    S.a_ready(cur);
    if constexpr (SP2) {
        PG8_STAGE(PG8_SB(0, 0), cB, voffB); PG8_STAGE(PG8_SB(0, 1), cB + hstep, voffB); PG8_STAGE_A(PG8_SA(0, 0), cA, 0); PG8_STAGE_A(PG8_SA(0, 1), cA, 1);
        if (wr == 1) PG8_BAR;
        PG8_WAIT_V(2); PG8_BAR;
        PG8_STAGE(PG8_SB(1, 0), cB + kstep, voffB); PG8_STAGE_A(PG8_SA(1, 0), cA + kstep, 0); PG8_STAGE(PG8_SB(1, 1), cB + hstep + kstep, voffB);
        PG8_WAIT_V(6); PG8_BAR;
    } else {
        PG8_STAGE(PG8_SB(0, 0), cB, voffB); PG8_STAGE_A(PG8_SA(0, 0), cA, 0); PG8_STAGE(PG8_SB(0, 1), cB + hstep, voffB); PG8_STAGE_A(PG8_SA(0, 1), cA, 1);
        if (wr == 1) PG8_BAR;
        PG8_WAIT_V(4); PG8_BAR;
        PG8_STAGE(PG8_SB(1, 0), cB + kstep, voffB); PG8_STAGE_A(PG8_SA(1, 0), cA + kstep, 0); PG8_STAGE(PG8_SB(1, 1), cB + hstep + kstep, voffB);
        PG8_WAIT_V(6); PG8_BAR;
    }
    for (;;) {
        nxt.e = cur.e; const bool has_next = S.next(ui + 1, nxt);
        const char* nA = has_next ? (const char*)g.A + (GATHER ? (size_t)0 : (size_t)nxt.pm * tstep) : cA; const char* nB = has_next ? (const char*)g.Bt + (size_t)nxt.e * g.b_estride + (size_t)nxt.pn * tstep : cB;
        if constexpr (GATHER) { if (has_next) { PG8_GPREFETCH(nxt); } }
        for (int t = 0; t < nt; t += 2) {
            const bool last = (t == nt - 2);
            const char* a1 = cA + (size_t)(t + 1) * kstep;
            const char* a2 = last ? nA : cA + (size_t)(t + 2) * kstep; const char* b2 = last ? nB : cB + (size_t)(t + 2) * kstep;
            const char* a3 = a2 + kstep; const char* b3 = b2 + kstep;
            if (last && has_next) S.a_ready(nxt);
            if constexpr (SP2) {
            PG8_LDB(B0, 0, 0); PG8_LDB(B1, 0, 1); PG8_SCHED; PG8_LDA(At, 0, 0); PG8_STAGE_A(PG8_SA(1, 1), a1, 1); PG8_GSWITCH;
            PG8_WAIT_V(8); PG8_WAIT_L(0); PG8_BAR; PG8_MMA(0, 0, At, B0); PG8_MMA(0, 1, At, B1); PG8_BAR; PG8_SCHED;
            PG8_LDA(At, 0, 1); PG8_STAGE(PG8_SB(0, 0), b2, voffB); PG8_STAGE(PG8_SB(0, 1), b2 + hstep, voffB); PG8_STAGE_A(PG8_SA(0, 0), a2, 0);
            PG8_WAIT_V(8); PG8_WAIT_L(0); PG8_BAR; PG8_MMA(1, 0, At, B0); PG8_MMA(1, 1, At, B1); PG8_BAR; PG8_SCHED;
            PG8_LDB(B0, 1, 0); PG8_LDB(B1, 1, 1); PG8_SCHED; PG8_LDA(At, 1, 0); PG8_STAGE_A(PG8_SA(0, 1), a2, 1);
            PG8_WAIT_V(8); PG8_WAIT_L(0); PG8_BAR; PG8_MMA(0, 0, At, B0); PG8_MMA(0, 1, At, B1); PG8_BAR; PG8_SCHED;
            PG8_LDA(At, 1, 1); PG8_STAGE(PG8_SB(1, 0), b3, voffB); PG8_STAGE(PG8_SB(1, 1), b3 + hstep, voffB); PG8_STAGE_A(PG8_SA(1, 0), a3, 0);
            PG8_WAIT_V(8); PG8_WAIT_L(0); PG8_BAR; PG8_MMA(1, 0, At, B0); PG8_MMA(1, 1, At, B1); PG8_BAR; PG8_SCHED;
            } else {
            PG8_LDB(B0, 0, 0); PG8_SCHED; PG8_LDA(At, 0, 0); PG8_STAGE_A(PG8_SA(1, 1), a1, 1); PG8_GSWITCH;
            PG8_WAIT_L(8); PG8_BAR; PG8_WAIT_L(0); PG8_MMA(0, 0, At, B0); PG8_BAR; PG8_SCHED;
            PG8_LDB(B1, 0, 1); PG8_STAGE(PG8_SB(0, 0), b2, voffB);
            PG8_BAR; PG8_WAIT_L(0); PG8_MMA(0, 1, At, B1); PG8_BAR;
            PG8_LDA(At, 0, 1); PG8_STAGE_A(PG8_SA(0, 0), a2, 0);
            PG8_BAR; PG8_WAIT_L(0); PG8_MMA(1, 0, At, B0); PG8_BAR; PG8_SCHED;
            PG8_STAGE(PG8_SB(0, 1), b2 + hstep, voffB);
            PG8_WAIT_V(6); PG8_BAR; PG8_MMA(1, 1, At, B1); PG8_BAR;
            PG8_LDB(B0, 1, 0); PG8_SCHED; PG8_LDA(At, 1, 0); PG8_STAGE_A(PG8_SA(0, 1), a2, 1);
            PG8_WAIT_L(8); PG8_BAR; PG8_WAIT_L(0); PG8_MMA(0, 0, At, B0); PG8_BAR; PG8_SCHED;
            PG8_LDB(B1, 1, 1); PG8_STAGE(PG8_SB(1, 0), b3, voffB);
            PG8_BAR; PG8_WAIT_L(0); PG8_MMA(0, 1, At, B1); PG8_BAR;
            PG8_LDA(At, 1, 1); PG8_STAGE_A(PG8_SA(1, 0), a3, 0);
            PG8_BAR; PG8_WAIT_L(0); PG8_MMA(1, 0, At, B0); PG8_BAR; PG8_SCHED;
            PG8_STAGE(PG8_SB(1, 1), b3 + hstep, voffB);
            PG8_WAIT_V(6); PG8_BAR; PG8_MMA(1, 1, At, B1); PG8_BAR;
            }
        }
        if constexpr (ALIGN_EPI) { if (wr == 0) PG8_BAR; }
        if constexpr (!Epi::AFTER_DRAIN) { E(acc, cur, wr, wc, fr, fq); S.done(cur); }
        if (!has_next) break;
#pragma unroll
        for (int a = 0; a < 2; ++a)
#pragma unroll
            for (int b = 0; b < 2; ++b)
#pragma unroll
                for (int m = 0; m < 4; ++m)
#pragma unroll
                    for (int n = 0; n < 2; ++n) acc[a][b][m][n] = (f32x4){0.f, 0.f, 0.f, 0.f};
        cur = nxt; cA = nA; cB = nB; ++ui;
        if constexpr (ALIGN_EPI) { if (wr == 1) PG8_BAR; }
    }
    PG8_WAIT_V(0);
    if constexpr (!ALIGN_EPI) { if (wr == 0) PG8_BAR; }
    PG8_BAR;
    if constexpr (Epi::AFTER_DRAIN) { E.fused(acc, cur, wr, wc, fr, fq, lds, wid, lane); S.done(cur); }
#undef PG8_SA
#undef PG8_SB
#undef PG8_STAGE
#undef PG8_STAGE_A
#undef PG8_GLOAD
#undef PG8_GPREFETCH
#undef PG8_GFROMLDS
#undef PG8_GSWITCH
#undef PG8_LDA
#undef PG8_LDB
#undef PG8_MMA
#undef PG8_WAIT_V
#undef PG8_WAIT_L
#undef PG8_BAR
#undef PG8_SCHED
}
}


namespace pg8 {
__device__ __forceinline__ float rcp_(float x) { return __builtin_amdgcn_rcpf(x); }
__device__ __forceinline__ float sigm_(float x) { return rcp_(1.f + __expf(-x)); }
template <int N> __device__ __forceinline__ float dpp_shr(float x) { return __builtin_bit_cast(float, __builtin_amdgcn_update_dpp(0, __builtin_bit_cast(int, x), 0x110 + N, 0xf, 0xf, false)); }
__device__ __forceinline__ u32x4 pack8(const f32x4 a, const f32x4 b) { u32x4 w; w.x = cvt_pk_bf16(a[0], a[1]); w.y = cvt_pk_bf16(a[2], a[3]); w.z = cvt_pk_bf16(b[0], b[1]); w.w = cvt_pk_bf16(b[2], b[3]); return w; }

struct EpiG1 {
    static constexpr bool PERM = true, AFTER_DRAIN = false;
    bf16_t *U, *QD, *KI, *KE, *V, *GS; float* DEC; const float* lb;
    __device__ __forceinline__ void operator()(const f32x4 (&acc)[2][2][4][2], const Unit& u, int wr, int wc, int fr, int fq) const {
        const int kind = u.pn >> 2, j = u.pn & 3;
        const int row0 = u.pm * BM + wr * 64 + fr;
        const int oc = 128 * j + wc * 32 + 8 * fq;
        if (kind == 0) {
#pragma unroll
            for (int ai = 0; ai < 2; ++ai)
#pragma unroll
                for (int m = 0; m < 4; ++m) { const size_t o = (size_t)(row0 + ai * HALF + m * 16) * 512 + oc; f32x4 r0, r1;
#pragma unroll
                    for (int e = 0; e < 4; ++e) { r0[e] = acc[ai][0][m][0][e] * sigm_(acc[ai][1][m][0][e]); r1[e] = acc[ai][0][m][1][e] * sigm_(acc[ai][1][m][1][e]); }
                    *(u32x4*)(U + o) = pack8(r0, r1); asm volatile("" ::: "memory"); }
        } else if (kind == 2) {
#pragma unroll
            for (int ai = 0; ai < 2; ++ai)
#pragma unroll
                for (int m = 0; m < 4; ++m) { const size_t o = (size_t)(row0 + ai * HALF + m * 16) * 512 + oc; f32x4 r0, r1;
#pragma unroll
                    for (int e = 0; e < 4; ++e) { const float g0 = acc[ai][1][m][0][e], g1 = acc[ai][1][m][1][e]; r0[e] = g0 * sigm_(g0); r1[e] = g1 * sigm_(g1); }
                    *(u32x4*)(V + o) = pack8(acc[ai][0][m][0], acc[ai][0][m][1]); *(u32x4*)(GS + o) = pack8(r0, r1); asm volatile("" ::: "memory"); }
        } else {
            float oml[8];
            { const f32x4 l0 = *(const f32x4*)(lb + oc), l1 = *(const f32x4*)(lb + oc + 4);
#pragma unroll
              for (int e = 0; e < 4; ++e) { oml[e] = 1.f - l0[e]; oml[4 + e] = 1.f - l1[e]; } }
#pragma unroll
            for (int ai = 0; ai < 2; ++ai) {
                unsigned qpk[4][2], kpk[4][2];
#pragma unroll
                for (int hc = 0; hc < 2; ++hc) {
                    float kk[4][4], bb[4][4];
#pragma unroll
                    for (int m = 0; m < 4; ++m)
#pragma unroll
                        for (int c = 0; c < 4; ++c) { const float f = acc[ai][1][m][hc][c]; const float k = oml[4 * hc + c] * rcp_(1.f + __expf(f)); kk[m][c] = k; bb[m][c] = __logf(1.f - k); }
#pragma unroll
                    for (int m = 0; m < 4; ++m)
#pragma unroll
                        for (int c = 0; c < 4; ++c) { bb[m][c] += dpp_shr<1>(bb[m][c]); bb[m][c] += dpp_shr<2>(bb[m][c]); bb[m][c] += dpp_shr<4>(bb[m][c]); bb[m][c] += dpp_shr<8>(bb[m][c]); }
                    float bl[4];
#pragma unroll
                    for (int c = 0; c < 4; ++c) { const float t0 = __shfl(bb[0][c], 15, 16), t1 = __shfl(bb[1][c], 15, 16), t2 = __shfl(bb[2][c], 15, 16), t3 = __shfl(bb[3][c], 15, 16);
                        bb[1][c] += t0; bb[2][c] += t0 + t1; bb[3][c] += (t0 + t1) + t2; bl[c] = ((t0 + t1) + t2) + t3; }
#pragma unroll
                    for (int m = 0; m < 4; ++m) { float qd[4], ki[4];
#pragma unroll
                        for (int c = 0; c < 4; ++c) { const float q = acc[ai][0][m][hc][c]; const float eb = __expf(bb[m][c]); qd[c] = q * sigm_(q) * eb; ki[c] = kk[m][c] * rcp_(eb); }
                        const unsigned q01 = cvt_pk_bf16(qd[0], qd[1]), q23 = cvt_pk_bf16(qd[2], qd[3]), k01 = cvt_pk_bf16(ki[0], ki[1]), k23 = cvt_pk_bf16(ki[2], ki[3]);
                        if (hc == 0) { qpk[m][0] = q01; qpk[m][1] = q23; kpk[m][0] = k01; kpk[m][1] = k23; }
                        else { const size_t o = (size_t)(row0 + ai * HALF + m * 16) * 512 + oc;
                            *(u32x4*)(QD + o) = (u32x4){qpk[m][0], qpk[m][1], q01, q23}; *(u32x4*)(KI + o) = (u32x4){kpk[m][0], kpk[m][1], k01, k23}; asm volatile("" ::: "memory"); } }
                    if (fr == 0) { float* dp = DEC + (size_t)(4 * u.pm + 2 * ai + wr) * 512 + oc + 4 * hc; f32x4 d0;
#pragma unroll
                        for (int e = 0; e < 4; ++e) d0[e] = __expf(bl[e]);
                        *(f32x4*)dp = d0; }
                }
            }
        }
    }
};

struct EpiE1 {
    static constexpr bool PERM = true, AFTER_DRAIN = false;
    bf16_t* HB;
    __device__ __forceinline__ void operator()(const f32x4 (&acc)[2][2][4][2], const Unit& u, int wr, int wc, int fr, int fq) const {
        const int row0 = u.pm * BM + wr * 64 + fr, oc = 128 * u.pn + wc * 32 + 8 * fq;
#pragma unroll
        for (int ai = 0; ai < 2; ++ai)
#pragma unroll
            for (int m = 0; m < 4; ++m) { const size_t o = (size_t)(row0 + ai * HALF + m * 16) * 256 + oc; f32x4 r0, r1;
#pragma unroll
                for (int e = 0; e < 4; ++e) { const float g0 = acc[ai][0][m][0][e], g1 = acc[ai][0][m][1][e]; r0[e] = g0 * sigm_(g0) * acc[ai][1][m][0][e]; r1[e] = g1 * sigm_(g1) * acc[ai][1][m][1][e]; }
                { const u32x4 w = pack8(r0, r1); const bf16_t* p = HB + o; asm volatile("global_store_dwordx4 %0, %1, off sc1\n\ts_nop 1" :: "v"(p), "v"(w) : "memory"); }
            }
    }
};
struct EpiE2 {
    static constexpr bool PERM = true, AFTER_DRAIN = false;
    bf16_t* YB;
    __device__ __forceinline__ void operator()(const f32x4 (&acc)[2][2][4][2], const Unit& u, int wr, int wc, int fr, int fq) const {
        const int row0 = u.pm * BM + wr * 64 + fr, col0 = u.pn * BM + wc * 32 + 8 * fq;
#pragma unroll
        for (int ai = 0; ai < 2; ++ai)
#pragma unroll
            for (int m = 0; m < 4; ++m) { bf16_t* rowp = YB + (size_t)(row0 + ai * HALF + m * 16) * 1024 + col0;
#pragma unroll
                for (int bj = 0; bj < 2; ++bj) *(u32x4*)(rowp + bj * HALF) = pack8(acc[ai][bj][m][0], acc[ai][bj][m][1]);
                asm volatile("" ::: "memory"); }
    }
};
struct GroupedOrder {
    const PG8_LAS int* tab; int nN, G, c;
    __device__ bool next(int i, Unit& u) const {
        const long L = (long)i * G + c; const int T = (int)(L / nN), pn = (int)(L % nN);
        if (T >= tab[32]) return false;
        int e = u.e; if (e < 0 || e > 31) e = 0;
        while (e < 31 && T >= tab[e + 1]) ++e;
        u.pm = T; u.pn = pn; u.e = e; u.r0 = (T - tab[e]) * 256; u.ne = tab[64 + e]; return true;
    }
    __device__ __forceinline__ void a_ready(const Unit&) const {}
    __device__ __forceinline__ void done(const Unit&) const {}
};
struct GroupedOrderPub : GroupedOrder {
    unsigned* donecnt;
    __device__ __forceinline__ void done(const Unit& u) const {
        asm volatile("s_waitcnt vmcnt(0)" ::: "memory");
        if ((threadIdx.x & 63) == 0) __hip_atomic_fetch_add(donecnt + 64 * u.pm, 1u, __ATOMIC_RELAXED, __HIP_MEMORY_SCOPE_AGENT);
    }
};
struct GroupedOrderDep : GroupedOrder {
    const unsigned* ready; unsigned need; unsigned* queue; PG8_LAS unsigned* slot; const unsigned* wgdone; unsigned nwg;
    __device__ bool next(int i, Unit& u) const {
        const unsigned L = (unsigned)__builtin_amdgcn_readfirstlane(slot[i & 1]); const unsigned seen = (unsigned)__builtin_amdgcn_readfirstlane(slot[2]);
        unsigned nxt_ticket = 0u; if (threadIdx.x == 0) nxt_ticket = __hip_atomic_fetch_add(queue, 1u, __ATOMIC_RELAXED, __HIP_MEMORY_SCOPE_AGENT);
        const int T = (int)(L / (unsigned)nN), pn = (int)(L % (unsigned)nN);
        const bool ok = T < tab[32];
        if (ok) { int e = u.e; if (e < 0 || e > 31) e = 0;
            while (e < 31 && T >= tab[e + 1]) ++e;
            u.pm = T; u.pn = pn; u.e = e; u.r0 = (T - tab[e]) * 256; u.ne = tab[64 + e];
            if (seen == 0u && threadIdx.x < 64) {
                unsigned alld = 0u;
                if ((unsigned)__builtin_amdgcn_readfirstlane(__hip_atomic_load(wgdone, __ATOMIC_RELAXED, __HIP_MEMORY_SCOPE_AGENT)) >= nwg) alld = 1u;
                else { unsigned polls = 0;
                    while ((unsigned)__builtin_amdgcn_readfirstlane(__hip_atomic_load(ready + 64 * T, __ATOMIC_RELAXED, __HIP_MEMORY_SCOPE_AGENT)) < need) { __builtin_amdgcn_s_sleep(2); if (++polls > (1u << 20)) break; } }
                __builtin_amdgcn_fence(__ATOMIC_ACQUIRE, "agent");
                asm volatile("s_waitcnt vmcnt(0)" ::: "memory");
                if (alld && threadIdx.x == 0) slot[2] = 1u;
            } }
        if (threadIdx.x == 0) slot[(i + 1) & 1] = nxt_ticket;
        asm volatile("s_waitcnt lgkmcnt(0)" ::: "memory"); __builtin_amdgcn_s_barrier(); asm volatile("" ::: "memory");
        return ok;
    }
};
__device__ __forceinline__ void grouped_table(PG8_LAS int* tab, const unsigned* cnt, int tid) {
    if (tid < 32) { const int n = (int)__hip_atomic_load(cnt + tid, __ATOMIC_RELAXED, __HIP_MEMORY_SCOPE_AGENT); tab[64 + tid] = n; int nt = (n + 255) >> 8, incl = nt;
#pragma unroll
        for (int o = 1; o < 32; o <<= 1) { const int t = __shfl_up(incl, o, 32); if (tid >= o) incl += t; }
        tab[tid] = incl - nt; if (tid == 31) tab[32] = incl; }
    __syncthreads();
}
}

constexpr int NWAVES = 8;
constexpr int RING_OFF = 0, RING_BYTES = 131072;
constexpr int LDSCTL_OFF = RING_BYTES, MISC_OFF = LDSCTL_OFF + 320;
constexpr int LDS_BYTES = 147456;
constexpr int CW_CNT = 0;
constexpr int CW_TMO = 64, CW_CODE = 65;
constexpr int CW_BAR = 4096;
constexpr int CW_WGDONE = 3136;
constexpr int CW_QUEUE = 3072;
constexpr int CW_DONE = 40960;
constexpr int CW_SEAM = 16384, SEAM_BANK = 128 * 64;

#define GAS __attribute__((address_space(1)))
#define LAS __attribute__((address_space(3)))
typedef unsigned v4u __attribute__((ext_vector_type(4)));
typedef unsigned v2u __attribute__((ext_vector_type(2)));
typedef float f32x4 __attribute__((ext_vector_type(4)));
typedef short bf16x8 __attribute__((ext_vector_type(8)));
typedef GAS unsigned gu32;
typedef GAS unsigned long long gu64;
#define RLX_AGENT __ATOMIC_RELAXED, __HIP_MEMORY_SCOPE_AGENT
#define LDS_WAIT() asm volatile("s_waitcnt lgkmcnt(0)" ::: "memory")
#define VM_WAIT() asm volatile("s_waitcnt vmcnt(0)" ::: "memory")
__device__ __forceinline__ unsigned long long rt() { return __builtin_amdgcn_s_memrealtime(); }
__device__ __forceinline__ unsigned pk2(float lo, float hi) { return (unsigned)f2bf(lo) | ((unsigned)f2bf(hi) << 16); }

#define XB_TMO      128
#define XB_XCNT(j)  (256  + 64 * (j))
#define XB_XSUB(j)  (1280 + 64 * (j))
#define XB_XGEN(j)  (2304 + 64 * (j))
#define XB_TOP      3328
#define XB_TOPGEN   3392
#define XCD_BAR_WORDS 3456
#define XB_SPIN_CAP (1u << 18)

__device__ __forceinline__ unsigned xb_ld(unsigned* p)              { return __hip_atomic_load(p, __ATOMIC_RELAXED, __HIP_MEMORY_SCOPE_AGENT); }
__device__ __forceinline__ unsigned xb_add(unsigned* p, unsigned v) { return __hip_atomic_fetch_add(p, v, __ATOMIC_RELAXED, __HIP_MEMORY_SCOPE_AGENT); }
__device__ __forceinline__ unsigned xb_xcc_id() { return (unsigned)__builtin_amdgcn_s_getreg((3 << 11) | 20) & 0xFu; }
#define XB_SPIN(cond, bar) do { unsigned _sp = 0; while (cond) { __builtin_amdgcn_s_sleep(1); \
    if ((++_sp & 255u) == 0u) { if (xb_ld(&(bar)[XB_TMO])) break; if (_sp > XB_SPIN_CAP) { atomicAdd(&(bar)[XB_TMO], 1u); break; } } } } while (0)

struct XcdBarrier {
    unsigned* bar; unsigned x;
    volatile LAS unsigned* st;
};

__device__ __forceinline__ XcdBarrier xcd_barrier_post(unsigned* bar, volatile LAS unsigned* st) {
    XcdBarrier b; b.bar = bar; b.x = xb_xcc_id(); b.st = st;
    if (threadIdx.x == 0) (void)xb_add(&bar[XB_XCNT(b.x)], 1u);
    return b;
}
__device__ __forceinline__ void xcd_barrier_complete(unsigned* bar, unsigned x, unsigned& nloc, unsigned& nx) {
    const unsigned G = gridDim.x * gridDim.y * gridDim.z;
    unsigned sum, cnt, mine, sp = 0u;
    for (;;) {
        sum = 0u; cnt = 0u; mine = 0u;
#pragma unroll
        for (unsigned j = 0; j < 16; ++j) { const unsigned c = xb_ld(&bar[XB_XCNT(j)]); sum += c; cnt += (c > 0u) ? 1u : 0u; mine = (j == x) ? c : mine; }
        if (sum == G) break;
        __builtin_amdgcn_s_sleep(1);
        if ((++sp & 255u) == 0u) { if (xb_ld(&bar[XB_TMO])) break; if (sp > XB_SPIN_CAP) { atomicAdd(&bar[XB_TMO], 1u); break; } }
    }
    nloc = mine > 0u ? mine : 1u; nx = cnt > 0u ? cnt : 1u;
}

__device__ __forceinline__ void xcd_barrier(const XcdBarrier& b) {
    asm volatile("s_waitcnt vmcnt(0)" ::: "memory");
    __syncthreads();
    if (threadIdx.x == 0) {
        unsigned* bar = b.bar;
        __builtin_amdgcn_s_waitcnt(0);
        unsigned nloc = b.st[0], nx = b.st[1];
        if (nloc == 0u) { xcd_barrier_complete(bar, b.x, nloc, nx); b.st[0] = nloc; b.st[1] = nx; }
        const unsigned old = xb_add(&bar[XB_XSUB(b.x)], 1u);
        const unsigned gen = old / nloc;
        if (old + 1u == (gen + 1u) * nloc) {
            __builtin_amdgcn_fence(__ATOMIC_RELEASE, "agent");
            asm volatile("s_waitcnt vmcnt(0)" ::: "memory");
            const unsigned og = xb_add(&bar[XB_TOP], 1u);
            const unsigned tg = og / nx;
            if (og + 1u == (tg + 1u) * nx) xb_add(&bar[XB_TOPGEN], 1u);
            else XB_SPIN(xb_ld(&bar[XB_TOPGEN]) == tg, bar);
            __builtin_amdgcn_fence(__ATOMIC_ACQUIRE, "agent");
            xb_add(&bar[XB_XGEN(b.x)], 1u);
            asm volatile("s_waitcnt vmcnt(0)" ::: "memory");
        } else {
            XB_SPIN(xb_ld(&bar[XB_XGEN(b.x)]) == gen, bar);
            __builtin_amdgcn_fence(__ATOMIC_ACQUIRE, "agent");
            asm volatile("s_waitcnt vmcnt(0)" ::: "memory");
        }
    }
    __syncthreads();
}


namespace hg {
typedef short s16x4 __attribute__((ext_vector_type(4)));
typedef short v4i16_t __attribute__((ext_vector_type(4)));
typedef float f32x16 __attribute__((ext_vector_type(16)));
typedef float f32x2_t __attribute__((ext_vector_type(2)));
typedef __bf16 bf16x2_t __attribute__((ext_vector_type(2)));
typedef LAS const char* lcp;
DI unsigned cvtpk(float lo, float hi) { f32x2_t v = {lo, hi}; bf16x2_t b = __builtin_convertvector(v, bf16x2_t); return __builtin_bit_cast(unsigned, b); }
DI unsigned off_b(unsigned row, unsigned ch) { return 256u * row + 16u * (ch ^ (((row & 3) << 2) | ((row >> 2) & 3))); }
DI int crow(int reg, int h) { return (reg & 3) + 8 * (reg >> 2) + 4 * h; }
DI s16x4 trrd(lcp p) { return __builtin_bit_cast(s16x4, __builtin_amdgcn_ds_read_tr16_b64_v4i16((LAS v4i16_t*)p)); }
DI bf16x8 cat(s16x4 lo, s16x4 hi) { return __builtin_shufflevector(lo, hi, 0, 1, 2, 3, 4, 5, 6, 7); }
DI unsigned tr_addr(int lane, int rb, int c) { const unsigned blk = (lane >> 4) & 1, q = (lane & 15) >> 2, p = lane & 3; return off_b(rb + q, 4 * c + 2 * blk + (p >> 1)) + 8 * (p & 1); }
template <int S> DI bf16x8 pack_step(const f32x16& x) { v4u p; p.x = cvtpk(x[8 * S], x[8 * S + 1]); p.y = cvtpk(x[8 * S + 2], x[8 * S + 3]); p.z = cvtpk(x[8 * S + 4], x[8 * S + 5]); p.w = cvtpk(x[8 * S + 6], x[8 * S + 7]); return __builtin_bit_cast(bf16x8, p); }
#define HG_MFMA(a, b, c) __builtin_amdgcn_mfma_f32_32x32x16_bf16((a), (b), (c), 0, 0, 0)

DI void tile_dma(const bf16* base, LAS unsigned char* img, int wave, int lane) {
#pragma unroll
    for (int i = 0; i < 2; ++i) { const int p = wave * 2 + i, row = 4 * p + (lane >> 4), ch = (lane & 15) ^ (((row & 3) << 2) | ((row >> 2) & 3));
        __builtin_amdgcn_global_load_lds((const unsigned*)(base + (size_t)row * 512 + ch * 8), (LAS unsigned*)(img + p * 1024), 16, 0, 0); }
}
constexpr int HG_DL = 133120, HG_NGL = 137216;

DI void x_unit(LAS unsigned char* L, int unit, const bf16* KI, const bf16* V, const float* DEC, float* LSEG, float* ASEG, int tid, int lane, int wave) {
    const int b = unit >> 5, h = (unit >> 3) & 3, seg = unit & 7;
    const int kbh = wave >> 2, nb = wave & 3, hh = lane >> 5;
    const size_t row0 = (size_t)b * SEQ + (size_t)seg * 512; const int c0 = (int)(row0 / CHUNK);
    LAS float* DL = (LAS float*)(L + HG_DL);
    f32x16 S2[2];
#pragma unroll
    for (int i = 0; i < 2; ++i)
#pragma unroll
        for (int r = 0; r < 16; ++r) S2[i][r] = 0.f;
    __syncthreads();
    if (tid < 256) { const int n = tid >> 5, c4 = (tid & 31) * 4; *(LAS f32x4*)(DL + n * 128 + c4) = *(const f32x4*)(DEC + (size_t)(c0 + n) * 512 + h * 128 + c4); }
#define HG_XDMA(n_) do { const size_t rn_ = row0 + (size_t)(n_) * CHUNK; LAS unsigned char* sl_ = L + ((n_) & 3) * 32768; tile_dma(KI + rn_ * 512 + h * 128, sl_, wave, lane); tile_dma(V + rn_ * 512 + h * 128, sl_ + 16384, wave, lane); } while (0)
    HG_XDMA(0); HG_XDMA(1); HG_XDMA(2);
    for (int n = 0; n < 8; ++n) {
        LAS unsigned char* KIi = L + (n & 3) * 32768; LAS unsigned char* Vi = KIi + 16384;
        if (n < 6) asm volatile("s_waitcnt vmcnt(8)" ::: "memory"); else if (n == 6) asm volatile("s_waitcnt vmcnt(4)" ::: "memory"); else asm volatile("s_waitcnt vmcnt(0)" ::: "memory");
        asm volatile("s_waitcnt lgkmcnt(0)" ::: "memory"); __builtin_amdgcn_s_barrier(); asm volatile("" ::: "memory");
        if (n + 3 < 8) HG_XDMA(n + 3);
#pragma unroll
        for (int ks = 0; ks < 4; ++ks) {
            const bf16x8 bv = cat(trrd((lcp)Vi + tr_addr(lane, 16 * ks + 8 * hh, nb)), trrd((lcp)Vi + tr_addr(lane, 16 * ks + 8 * hh + 4, nb)));
#pragma unroll
            for (int i = 0; i < 2; ++i) { const int kb = 2 * kbh + i;
                const bf16x8 a = cat(trrd((lcp)KIi + tr_addr(lane, 16 * ks + 8 * hh, kb)), trrd((lcp)KIi + tr_addr(lane, 16 * ks + 8 * hh + 4, kb)));
                S2[i] = HG_MFMA(a, bv, S2[i]); }
        }
#pragma unroll
        for (int i = 0; i < 2; ++i)
#pragma unroll
            for (int g = 0; g < 4; ++g) { const f32x4 d = *(const LAS f32x4*)(DL + n * 128 + 32 * (2 * kbh + i) + 8 * g + 4 * hh);
#pragma unroll
                for (int e = 0; e < 4; ++e) S2[i][4 * g + e] *= d[e]; }
    }
#pragma unroll
    for (int i = 0; i < 2; ++i) { const int kb = 2 * kbh + i; float* lp = LSEG + ((((size_t)unit * 4 + nb) * 4 + kb) * 16) * 64 + lane;
#pragma unroll
        for (int r = 0; r < 16; ++r) lp[r * 64] = S2[i][r]; }
    if (tid < 128) { float a = 1.f;
#pragma unroll
        for (int n = 0; n < 8; ++n) a *= DL[n * 128 + tid];
        ASEG[unit * 128 + tid] = a; }
#undef HG_XDMA
}

DI void y_unit(LAS unsigned char* L, int unit, const bf16* QD, const bf16* KI, const bf16* V, const bf16* GS, const float* DEC, const float* LSEG,
               bf16* YCAT, int tid, int lane, int wave) {
    const int b = unit >> 5, h = (unit >> 3) & 3, seg = unit & 7;
    const int cb = wave >> 2, nb = wave & 3, r = lane & 31, hh = lane >> 5;
    const size_t row0 = (size_t)b * SEQ + (size_t)seg * 512; const int c0 = (int)(row0 / CHUNK);
    LAS float* OST = (LAS float*)(L + 98304);
    LAS float* DL = (LAS float*)(L + HG_DL); LAS float* NGL = (LAS float*)(L + HG_NGL);
    __syncthreads();
    if (tid < 256) { const int n = tid >> 5, c4 = (tid & 31) * 4; *(LAS f32x4*)(DL + n * 128 + c4) = *(const f32x4*)(DEC + (size_t)(c0 + n) * 512 + h * 128 + c4); }
    { const size_t o = row0 * 512 + h * 128; tile_dma(QD + o, L, wave, lane); tile_dma(KI + o, L + 16384, wave, lane); tile_dma(V + o, L + 32768, wave, lane); }
    f32x16 S[4];
#pragma unroll
    for (int kb = 0; kb < 4; ++kb)
#pragma unroll
        for (int q = 0; q < 16; ++q) S[kb][q] = 0.f;
    if (seg > 0) { const float* lp = LSEG + (((size_t)(unit - 1) * 4 + nb) * 4) * 16 * 64 + lane;
#pragma unroll
        for (int kb = 0; kb < 4; ++kb)
#pragma unroll
            for (int q = 0; q < 16; ++q) S[kb][q] = lp[(kb * 16 + q) * 64]; }
    const int ec = tid >> 3, edv = (tid & 7) * 16;
    for (int n = 0; n < 8; ++n) {
        LAS unsigned char* QDi = L + (n & 1) * 49152; LAS unsigned char* KIi = QDi + 16384; LAS unsigned char* Vi = QDi + 32768;
        __syncthreads();
        const size_t grow = row0 + (size_t)n * CHUNK + ec;
        const v4u g0 = *(const GAS v4u*)(GS + grow * 512 + h * 128 + edv), g1 = *(const GAS v4u*)(GS + grow * 512 + h * 128 + edv + 8);
        if (n + 1 < 8) { const size_t o = (row0 + (size_t)(n + 1) * CHUNK) * 512 + h * 128; LAS unsigned char* nx = L + ((n + 1) & 1) * 49152;
            tile_dma(QD + o, nx, wave, lane); tile_dma(KI + o, nx + 16384, wave, lane); tile_dma(V + o, nx + 32768, wave, lane); }
        f32x16 pt0, pt1;
#pragma unroll
        for (int q = 0; q < 16; ++q) { pt0[q] = 0.f; pt1[q] = 0.f; }
#pragma unroll
        for (int ks = 0; ks < 8; ++ks) {
            const bf16x8 bq = *(const LAS bf16x8*)(QDi + off_b(32 * cb + r, 2 * ks + hh));
            const bf16x8 a0 = *(const LAS bf16x8*)(KIi + off_b(r, 2 * ks + hh));
            pt0 = HG_MFMA(a0, bq, pt0);
            if (cb == 1) { const bf16x8 a1 = *(const LAS bf16x8*)(KIi + off_b(32 + r, 2 * ks + hh)); pt1 = HG_MFMA(a1, bq, pt1); }
        }
        if (cb == 0) {
#pragma unroll
            for (int q = 0; q < 16; ++q) if (crow(q, hh) > r) pt0[q] = 0.f;
        } else {
#pragma unroll
            for (int q = 0; q < 16; ++q) if (crow(q, hh) > r) pt1[q] = 0.f;
        }
        f32x16 O;
#pragma unroll
        for (int q = 0; q < 16; ++q) O[q] = 0.f;
        { const bf16x8 x0 = pack_step<0>(pt0), x1 = pack_step<1>(pt0);
          const bf16x8 v0 = cat(trrd((lcp)Vi + tr_addr(lane, 0 + 4 * hh, nb)), trrd((lcp)Vi + tr_addr(lane, 8 + 4 * hh, nb)));
          const bf16x8 v1 = cat(trrd((lcp)Vi + tr_addr(lane, 16 + 4 * hh, nb)), trrd((lcp)Vi + tr_addr(lane, 24 + 4 * hh, nb)));
          O = HG_MFMA(x0, v0, O); O = HG_MFMA(x1, v1, O); }
        if (cb == 1) { const bf16x8 x0 = pack_step<0>(pt1), x1 = pack_step<1>(pt1);
          const bf16x8 v0 = cat(trrd((lcp)Vi + tr_addr(lane, 32 + 4 * hh, nb)), trrd((lcp)Vi + tr_addr(lane, 40 + 4 * hh, nb)));
          const bf16x8 v1 = cat(trrd((lcp)Vi + tr_addr(lane, 48 + 4 * hh, nb)), trrd((lcp)Vi + tr_addr(lane, 56 + 4 * hh, nb)));
          O = HG_MFMA(x0, v0, O); O = HG_MFMA(x1, v1, O); }
#pragma unroll
        for (int kb = 0; kb < 4; ++kb) {
            const bf16x8 xb0 = pack_step<0>(S[kb]), xb1 = pack_step<1>(S[kb]);
            const unsigned o0 = off_b(32 * cb + r, 4 * kb) + 8 * hh, o1 = off_b(32 * cb + r, 4 * kb + 1) + 8 * hh, o2 = off_b(32 * cb + r, 4 * kb + 2) + 8 * hh, o3 = off_b(32 * cb + r, 4 * kb + 3) + 8 * hh;
            const bf16x8 qa0 = cat(*(const LAS s16x4*)(QDi + o0), *(const LAS s16x4*)(QDi + o1));
            const bf16x8 qa1 = cat(*(const LAS s16x4*)(QDi + o2), *(const LAS s16x4*)(QDi + o3));
            O = HG_MFMA(qa0, xb0, O); O = HG_MFMA(qa1, xb1, O);
        }
        if (n + 1 < 8) {
#pragma unroll
            for (int ks = 0; ks < 4; ++ks) {
                const bf16x8 bv = cat(trrd((lcp)Vi + tr_addr(lane, 16 * ks + 8 * hh, nb)), trrd((lcp)Vi + tr_addr(lane, 16 * ks + 8 * hh + 4, nb)));
#pragma unroll
                for (int kb = 0; kb < 4; ++kb) {
                    const bf16x8 a = cat(trrd((lcp)KIi + tr_addr(lane, 16 * ks + 8 * hh, kb)), trrd((lcp)KIi + tr_addr(lane, 16 * ks + 8 * hh + 4, kb)));
                    S[kb] = HG_MFMA(a, bv, S[kb]); }
            }
#pragma unroll
            for (int kb = 0; kb < 4; ++kb)
#pragma unroll
                for (int g = 0; g < 4; ++g) { const f32x4 d = *(const LAS f32x4*)(DL + n * 128 + 32 * kb + 8 * g + 4 * hh);
#pragma unroll
                    for (int e = 0; e < 4; ++e) S[kb][4 * g + e] *= d[e]; }
        }
#pragma unroll
        for (int q = 0; q < 16; ++q) OST[(32 * cb + crow(q, hh)) * 128 + 32 * nb + r] = O[q];
        asm volatile("s_waitcnt lgkmcnt(0)" ::: "memory"); __builtin_amdgcn_s_barrier(); asm volatile("" ::: "memory");
        { f32x4 o4[4]; float ss = 0.f;
#pragma unroll
          for (int i = 0; i < 4; ++i) { o4[i] = *(const LAS f32x4*)(OST + ec * 128 + edv + 4 * i); ss += (o4[i].x * o4[i].x + o4[i].y * o4[i].y) + (o4[i].z * o4[i].z + o4[i].w * o4[i].w); }
          ss += __shfl_xor(ss, 1); ss += __shfl_xor(ss, 2); ss += __shfl_xor(ss, 4);
          const float rstd = 1.f / sqrtf(ss * (1.f / DV) + EPS);
          const unsigned gw_[8] = {g0.x, g0.y, g0.z, g0.w, g1.x, g1.y, g1.z, g1.w};
          unsigned ow[8];
#pragma unroll
          for (int i = 0; i < 4; ++i) { const f32x4 gn = *(const LAS f32x4*)(NGL + edv + 4 * i);
              const float a0 = o4[i].x * rstd * gn.x * __uint_as_float(gw_[2 * i] << 16), a1 = o4[i].y * rstd * gn.y * __uint_as_float(gw_[2 * i] & 0xffff0000u);
              const float a2 = o4[i].z * rstd * gn.z * __uint_as_float(gw_[2 * i + 1] << 16), a3 = o4[i].w * rstd * gn.w * __uint_as_float(gw_[2 * i + 1] & 0xffff0000u);
              ow[2 * i] = cvtpk(a0, a1); ow[2 * i + 1] = cvtpk(a2, a3); }
          bf16* yp = YCAT + grow * D + 512 + h * 128 + edv;
          *(GAS v4u*)yp = (v4u){ow[0], ow[1], ow[2], ow[3]}; *(GAS v4u*)(yp + 8) = (v4u){ow[4], ow[5], ow[6], ow[7]}; }
    }
}

DI void conv_stage_w(LAS unsigned char* L, const float* dw, int tid) {
    LAS unsigned short* WT = (LAS unsigned short*)(L + 96256);
    float wv[CW];
#pragma unroll
    for (int j = 0; j < CW; ++j) wv[j] = dw[j * DCONV + tid];
#pragma unroll
    for (int j = 0; j < CW; ++j) WT[j * DCONV + tid] = f2bf(wv[j]);
}
DI void conv_tile_ld(v4u (&rg)[12], int cu, const bf16* U, int tid) {
    const size_t t0 = (size_t)cu * 64; const int trel = (int)(t0 % SEQ);
#pragma unroll
    for (int i = 0; i < 12; ++i) { const int q = tid + 512 * i, row = q >> 6, ch = q & 63; rg[i] = (v4u){0u, 0u, 0u, 0u};
        if (q < 94 * 64 && trel - 30 + row >= 0) rg[i] = *(const GAS v4u*)(U + (t0 + row - 30) * 512 + ch * 8); }
}
DI void conv_tile_st(const v4u (&rg)[12], LAS unsigned char* L, int tid) {
#pragma unroll
    for (int i = 0; i < 12; ++i) { const int q = tid + 512 * i, row = q >> 6, ch = q & 63; if (q < 94 * 64) *(LAS v4u*)(L + row * 1024 + ch * 16) = rg[i]; }
}
DI void conv_unit(LAS unsigned char* L, int cu, const float* dwb, const float* lng, const float* lnb, bf16* YCAT, int tid, int lane, int wave) {
    const size_t t0 = (size_t)cu * 64;
#pragma unroll 1
    for (int pass = 0; pass < 2; ++pass) {
        const int rbase = 8 * wave + 4 * pass;
        float acc[4][8];
        { const f32x4 b0 = *(const f32x4*)(dwb + 8 * lane), b1 = *(const f32x4*)(dwb + 8 * lane + 4);
#pragma unroll
          for (int rr = 0; rr < 4; ++rr) { acc[rr][0] = b0.x; acc[rr][1] = b0.y; acc[rr][2] = b0.z; acc[rr][3] = b0.w; acc[rr][4] = b1.x; acc[rr][5] = b1.y; acc[rr][6] = b1.z; acc[rr][7] = b1.w; } }
        float wA[8], wB[8], wC[8], wD[8];
#pragma unroll
        for (int c = 0; c < 8; ++c) { wA[c] = 0.f; wB[c] = 0.f; wC[c] = 0.f; wD[c] = 0.f; }
        LAS const unsigned char* up = L + rbase * 1024 + lane * 16; LAS const unsigned char* wp = L + 96256 + lane * 16;
#define CV_UNPK(dst, v) do { dst[0] = __uint_as_float((v).x << 16); dst[1] = __uint_as_float((v).x & 0xffff0000u); dst[2] = __uint_as_float((v).y << 16); dst[3] = __uint_as_float((v).y & 0xffff0000u); \
        dst[4] = __uint_as_float((v).z << 16); dst[5] = __uint_as_float((v).z & 0xffff0000u); dst[6] = __uint_as_float((v).w << 16); dst[7] = __uint_as_float((v).w & 0xffff0000u); } while (0)
#define CV_STEP(i, W0, W1, W2, W3) do { v4u w4 = {0u, 0u, 0u, 0u}; if ((i) <= 30) w4 = *(const LAS v4u*)(wp + (i) * 1024); CV_UNPK(W0, w4); \
        const v4u u4 = *(const LAS v4u*)(up + (i) * 1024); float u[8]; CV_UNPK(u, u4); \
        _Pragma("unroll") for (int c = 0; c < 8; ++c) { acc[0][c] += W0[c] * u[c]; acc[1][c] += W1[c] * u[c]; acc[2][c] += W2[c] * u[c]; acc[3][c] += W3[c] * u[c]; } } while (0)
#pragma unroll 1
        for (int ib = 0; ib < 9; ++ib) { const int i0 = 4 * ib;
            CV_STEP(i0, wA, wD, wC, wB); CV_STEP(i0 + 1, wB, wA, wD, wC); CV_STEP(i0 + 2, wC, wB, wA, wD); CV_STEP(i0 + 3, wD, wC, wB, wA); }
#undef CV_STEP
#undef CV_UNPK
        const f32x4 lg0 = *(const f32x4*)(lng + 8 * lane), lg1 = *(const f32x4*)(lng + 8 * lane + 4), lb0 = *(const f32x4*)(lnb + 8 * lane), lb1 = *(const f32x4*)(lnb + 8 * lane + 4);
        const float lgv[8] = {lg0.x, lg0.y, lg0.z, lg0.w, lg1.x, lg1.y, lg1.z, lg1.w}, lbv[8] = {lb0.x, lb0.y, lb0.z, lb0.w, lb1.x, lb1.y, lb1.z, lb1.w};
#pragma unroll
        for (int rr = 0; rr < 4; ++rr) {
            float s1 = 0.f, s2 = 0.f;
#pragma unroll
            for (int c = 0; c < 8; ++c) { s1 += acc[rr][c]; s2 += acc[rr][c] * acc[rr][c]; }
#pragma unroll
            for (int o = 1; o < 64; o <<= 1) { s1 += __shfl_xor(s1, o); s2 += __shfl_xor(s2, o); }
            const float mu = s1 * (1.f / DCONV), var = fmaxf(s2 * (1.f / DCONV) - mu * mu, 0.f), rstd = 1.f / sqrtf(var + EPS);
            float y[8];
#pragma unroll
            for (int c = 0; c < 8; ++c) { const float z = (acc[rr][c] - mu) * rstd * lgv[c] + lbv[c]; y[c] = z * pg8::sigm_(z); }
            *(GAS v4u*)(YCAT + (t0 + rbase + rr) * D + 8 * lane) = (v4u){cvtpk(y[0], y[1]), cvtpk(y[2], y[3]), cvtpk(y[4], y[5]), cvtpk(y[6], y[7])};
        }
    }
}
}

struct Args { const float* in[23]; float* out; unsigned char* ws; int ph_lo, ph_hi, bar_region, pad; };

__device__ __forceinline__ float wave_sum(float v) {
#pragma unroll
    for (int o = 1; o < 64; o <<= 1) v += __shfl_xor(v, o);
    return v;
}
struct TrItem { const float* src; bf16* dst; int ldsrc, srccol0, k0, lddst, dstrow0; };
__device__ __forceinline__ void tr_ld(float (&tv)[32], const TrItem& t, int lane) {
#pragma unroll
    for (int i = 0; i < 32; ++i) { const int kk = 2 * i + (lane >> 5); tv[i] = t.src[(size_t)(t.k0 + kk) * t.ldsrc + t.srccol0 + (lane & 31)]; }
}
__device__ __forceinline__ void tr_st(const float (&tv)[32], const TrItem& t, LAS float* scr, int lane) {
#pragma unroll
    for (int i = 0; i < 32; ++i) { const int kk = 2 * i + (lane >> 5); scr[kk * 33 + (lane & 31)] = tv[i]; }
    LDS_WAIT(); asm volatile("" ::: "memory");
    const int c = lane & 7;
#pragma unroll
    for (int j = 0; j < 4; ++j) { const int n = (lane >> 3) + 8 * j; const LAS float* s = scr + (8 * c) * 33 + n;
        v4u o; o.x = hg::cvtpk(s[0 * 33], s[1 * 33]); o.y = hg::cvtpk(s[2 * 33], s[3 * 33]); o.z = hg::cvtpk(s[4 * 33], s[5 * 33]); o.w = hg::cvtpk(s[6 * 33], s[7 * 33]);
        *(GAS v4u*)(t.dst + (size_t)(t.dstrow0 + n) * t.lddst + t.k0 + 8 * c) = o; }
    LDS_WAIT(); asm volatile("" ::: "memory");
}

__global__ void __launch_bounds__(NWAVES * 64, 2) fused_fwd(Args args) {
    extern __shared__ __attribute__((aligned(16))) unsigned char lds[];
    LAS unsigned char* L = (LAS unsigned char*)lds;
    volatile LAS unsigned* MISC = (volatile LAS unsigned*)(L + MISC_OFF);
    const int tid0 = threadIdx.x, wave = __builtin_amdgcn_readfirstlane(tid0 >> 6);
    const int G = gridDim.x, bx = blockIdx.x;
    const int vcu = (G % 8 == 0) ? (bx % 8) * (G / 8) + bx / 8 : bx;
    typedef const __attribute__((address_space(4))) Args* kargp;
#define KARGS() ({ kargp p_ = (kargp)__builtin_amdgcn_kernarg_segment_ptr(); asm volatile("" : "+s"(p_)); p_; })
#define PH_SETUP int tid = threadIdx.x; asm volatile("" : "+v"(tid)); const int lane = tid & 63; (void)lane; kargp A_ = KARGS(); unsigned char* ws = A_->ws; gu32* ctl = (gu32*)(ws + WS_CTL); const float* x = A_->in[0]; float* out = A_->out; \
    float* MOD = (float*)(ws + WS_MOD); float* LB = (float*)(ws + WS_LB); float* CV = (float*)(ws + WS_CV); \
    bf16 *WIN = (bf16*)(ws + WS_WIN), *WOUT = (bf16*)(ws + WS_WOUT), *WGU = (bf16*)(ws + WS_WGU), *WD = (bf16*)(ws + WS_WD), *WR = (bf16*)(ws + WS_WR); \
    bf16 *HA = (bf16*)(ws + WS_A), *U = (bf16*)(ws + WS_U), *QD = (bf16*)(ws + WS_QD), *KI = (bf16*)(ws + WS_KI), *KE = (bf16*)(ws + WS_KE), *V = (bf16*)(ws + WS_V), *GS = (bf16*)(ws + WS_GS); \
    bf16 *HB = (bf16*)(ws + WS_HB), *YB = (bf16*)(ws + WS_YB), *YCAT = (bf16*)(ws + WS_C); float* DEC = (float*)(ws + WS_DEC); \
    int* TOKE = (int*)(ws + WS_TOKE); float* TOKW = (float*)(ws + WS_TOKW); int* TOKP = (int*)(ws + WS_TOKP); int* LIST = (int*)(ws + WS_LIST); \
    (void)x; (void)out; (void)MOD; (void)LB; (void)CV; (void)WIN; (void)WOUT; (void)WGU; (void)WD; (void)WR; (void)HA; (void)U; (void)QD; (void)KI; (void)KE; (void)V; (void)GS; (void)HB; (void)YB; (void)YCAT; (void)DEC; (void)TOKE; (void)TOKW; (void)TOKP; (void)LIST; (void)ctl;
    for (int u = tid0; u < (LDS_BYTES - LDSCTL_OFF) / 4; u += NWAVES * 64) ((LAS unsigned*)(L + LDSCTL_OFF))[u] = 0u;
    __syncthreads();
    XcdBarrier bar = xcd_barrier_post((unsigned*)((gu32*)(args.ws + WS_CTL) + CW_BAR) + args.bar_region * XCD_BAR_WORDS, MISC + 8);
    const int lo = args.ph_lo, hi = args.ph_hi;
#ifdef PROBE_T
#define STAMP(i) do { if (tid0 == 0) ((volatile LAS unsigned long long*)(L + LDSCTL_OFF))[i] = __builtin_amdgcn_s_memrealtime(); } while (0)
#else
#define STAMP(i) do { } while (0)
#endif
    STAMP(0);
#ifndef PH_ENABLE
#define PH_ENABLE 0x3FF
#endif
#define IN(k) ((((k) >= 10) || ((PH_ENABLE >> (k)) & 1)) && lo <= (k) && (k) < hi)
#define BOTH(k) (IN(k) && IN((k) + 1))
#define GRID_BAR() xcd_barrier(bar)
    const int gw = vcu * NWAVES + wave, NGW = G * NWAVES;

    if (IN(0)) {
        PH_SETUP
        const float* c = A_->in[1]; const float* w_ada = A_->in[2]; const float* b_ada = A_->in[3];
        const float* w_in = A_->in[6]; const float* w_out = A_->in[13]; const float* w_gate = A_->in[20]; const float* w_up = A_->in[21]; const float* w_down = A_->in[22];
        if (bx < 192) {
            LAS float* sc = (LAS float*)(L);
            LAS float* red = (LAS float*)(L + 32768);
            for (int i = tid; i < BATCH * D; i += 512) { const float v = c[i]; sc[i] = v / (1.f + __expf(-v)); }
            __syncthreads();
            const int col = tid & 31, kg = tid >> 5, n0 = bx * 32;
            float a8[BATCH];
#pragma unroll
            for (int b = 0; b < BATCH; ++b) a8[b] = 0.f;
#pragma unroll 1
            for (int k0 = 0; k0 < 64; k0 += 16) { float wv[16];
#pragma unroll
                for (int kk = 0; kk < 16; ++kk) wv[kk] = w_ada[(size_t)(kg * 64 + k0 + kk) * (6 * D) + n0 + col];
#pragma unroll
                for (int kk = 0; kk < 16; ++kk) { const int k = kg * 64 + k0 + kk;
#pragma unroll
                    for (int b = 0; b < BATCH; ++b) a8[b] += sc[b * D + k] * wv[kk]; } }
#pragma unroll
            for (int b = 0; b < BATCH; ++b) red[(kg * BATCH + b) * 32 + col] = a8[b];
            __syncthreads();
            if (tid < 256) { const int b = tid >> 5, cc = tid & 31; float s = 0.f;
#pragma unroll
                for (int k2 = 0; k2 < 16; ++k2) s += red[(k2 * BATCH + b) * 32 + cc];
                MOD[b * 6 * D + n0 + cc] = s + b_ada[n0 + cc]; }
            __syncthreads();
        } else if (bx == 192) {
            const float* lbl = A_->in[11];
            { const float a = lbl[tid], b = lbl[DREC + tid], m = fmaxf(a, b); const float ea = __expf(a - m), eb = __expf(b - m); LB[tid] = ea / (ea + eb); }
        }
        { const float* wrg = A_->in[16]; const float* wre = A_->in[18];
          for (int i = bx * 512 + tid; i < 48 * D; i += G * 512) { const int n = i / D, k = i % D; float v = 0.f; if (n < 4) v = wrg[k * 4 + n]; else if (n < 36) v = wre[k * 32 + (n - 4)]; WR[i] = (bf16)f2bf(v); } }
        LAS float* scr = (LAS float*)(L + RING_OFF + wave * 16384);
        constexpr int I_IN = 16 * 96, I_OUT = 16 * 32, I_GU = NEXP * 16 * 16, I_D = NEXP * 4 * 32;
        constexpr int NIT = I_IN + I_OUT + I_GU + I_D;
        auto decode = [&](int it) -> TrItem { int r = it; TrItem t;
            if (r < I_IN) { const int kb = r / 96, nb = r % 96; t = TrItem{w_in, WIN, DIN, win_src_col(32 * nb), 64 * kb, D, 32 * nb}; return t; } r -= I_IN;
            if (r < I_OUT) { const int kb = r / 32, nb = r % 32; t = TrItem{w_out, WOUT, D, 32 * nb, 64 * kb, D, 32 * nb}; return t; } r -= I_OUT;
            if (r < I_GU) { const int e = r / 256, kb = (r % 256) / 16, nb = r % 16; const int n = 32 * nb, pn = n >> 8, half = (n >> 7) & 1, ch = 128 * pn + (n & 127);
                t = TrItem{(half ? w_up : w_gate) + (size_t)e * D * DEXP, WGU + (size_t)e * 512 * D, DEXP, ch, 64 * kb, D, n}; return t; } r -= I_GU;
            { const int e = r / 128, kb = (r % 128) / 32, nb = r % 32; t = TrItem{w_down + (size_t)e * DEXP * D, WD + (size_t)e * D * DEXP, D, 32 * nb, 64 * kb, DEXP, 32 * nb}; return t; } };
        const bool split = (G == 256); const int NA = split ? 6 * NGW : NIT; const int xw = (bx - 192) * NWAVES + wave;
        auto item = [&](int j) -> int { if (j < NA / NGW || !split) { const int it = j * NGW + gw; return it < NA || !split ? (it < NIT ? it : -1) : -1; }
                                         if (bx < 192) return -1; const int it = NA + (j - NA / NGW) * 512 + xw; return it < NIT ? it : -1; };
        { int j = 0; TrItem ta, tb; float va[32], vb[32];
          int it = item(0); if (it >= 0) { ta = decode(it); tr_ld(va, ta, lane); }
          while (it >= 0) {
              const int it2 = item(j + 1); if (it2 >= 0) { tb = decode(it2); tr_ld(vb, tb, lane); }
              tr_st(va, ta, scr, lane);
              if (it2 < 0) break;
              const int it3 = item(j + 2); if (it3 >= 0) { ta = decode(it3); tr_ld(va, ta, lane); }
              tr_st(vb, tb, scr, lane);
              it = it3; j += 2; } }
        STAMP(1); if (BOTH(0)) GRID_BAR(); STAMP(2);
    }
    if (IN(1)) {
        PH_SETUP
        const float* g1 = A_->in[4]; const float* gpost = A_->in[5]; const float* gpre = A_->in[14]; const float* gpostf = A_->in[15];
        for (int i = bx * 512 + tid; i < BATCH * D; i += G * 512) { const int b = i / D, cc = i % D; const float* mb = MOD + b * 6 * D;
            CV[i] = mb[2 * D + cc] * gpost[cc]; CV[BATCH * D + i] = gpre[cc] * (1.f + mb[4 * D + cc]); CV[2 * BATCH * D + i] = mb[3 * D + cc]; CV[3 * BATCH * D + i] = mb[5 * D + cc] * gpostf[cc]; }
        auto p1_ld = [&](f32x4 (&v)[4][4], int m0) {
#pragma unroll
            for (int q = 0; q < 4; ++q) { int m = m0 + q * NGW; if (m >= M) m = m0;
                const GAS f32x4* xr = (const GAS f32x4*)(x + (size_t)m * D) + lane;
#pragma unroll
                for (int j = 0; j < 4; ++j) v[q][j] = xr[64 * j]; } };
        auto p1_do = [&](const f32x4 (&v)[4][4], int m0) {
#pragma unroll
            for (int q = 0; q < 4; ++q) { int m = m0 + q * NGW; if (m >= M) m = m0; const int b = m / SEQ; const float* mb = MOD + b * 6 * D; float s = 0.f;
#pragma unroll
                for (int j = 0; j < 4; ++j) s += (v[q][j].x * v[q][j].x + v[q][j].y * v[q][j].y) + (v[q][j].z * v[q][j].z + v[q][j].w * v[q][j].w);
                const float rstd = 1.f / sqrtf(wave_sum(s) * (1.f / D) + EPS);
                GAS unsigned long long* o8 = (GAS unsigned long long*)(HA + (size_t)m * D) + lane;
#pragma unroll
                for (int j = 0; j < 4; ++j) { const int cc = 4 * lane + 256 * j; const f32x4 gg = *(const f32x4*)(g1 + cc), sc = *(const f32x4*)(mb + D + cc), sh = *(const f32x4*)(mb + cc);
                    const f32x4 o = (v[q][j] * rstd) * (gg * (sc + 1.f)) + sh;
                    o8[64 * j] = (unsigned long long)hg::cvtpk(o.x, o.y) | ((unsigned long long)hg::cvtpk(o.z, o.w) << 32); } } };
        { f32x4 va[4][4], vb[4][4]; int m0 = gw;
          if (m0 < M) p1_ld(va, m0);
          while (m0 < M) {
              const int m1 = m0 + 4 * NGW; if (m1 < M) p1_ld(vb, m1);
              p1_do(va, m0);
              m0 = m1; if (m0 >= M) break;
              const int m2 = m0 + 4 * NGW; if (m2 < M) p1_ld(va, m2);
              p1_do(vb, m0);
              m0 = m2; } }
        STAMP(3); if (BOTH(1)) GRID_BAR(); STAMP(4);
    }
    if (IN(2)) {
        PH_SETUP
        pg8::Gemm g{HA, WIN, M, DIN, D, 0, nullptr, 0}; pg8::StaticOrder S; S.init(M, DIN, G, bx);
        pg8::EpiG1 E{U, QD, KI, KE, V, GS, DEC, LB};
        pg8::gemm_phase<pg8::EpiG1, pg8::StaticOrder, true, true, false>(L + RING_OFF, g, S, E);
        STAMP(5); if (BOTH(2)) GRID_BAR(); STAMP(6);
    }
    if (IN(3)) {
        PH_SETUP
        const float* dw = A_->in[7]; const float* dwb = A_->in[8]; const float* lng = A_->in[9]; const float* lnb = A_->in[10];
        float* LSEG = (float*)(ws + WS_LSEG); float* ASEG = (float*)(ws + WS_ASEG);
        hg::conv_stage_w(L, dw, tid);
        { v4u rg[12]; if (bx < M / 64) hg::conv_tile_ld(rg, bx, U, tid);
          for (int cu = bx; cu < M / 64; cu += G) {
              __syncthreads();
              hg::conv_tile_st(rg, L, tid);
              if (cu + G < M / 64) hg::conv_tile_ld(rg, cu + G, U, tid);
              __syncthreads();
              hg::conv_unit(L, cu, dwb, lng, lnb, YCAT, tid, lane, wave); } }
        for (int un = bx; un < BATCH * NHEAD * 8; un += G) hg::x_unit(L, un, KI, V, DEC, LSEG, ASEG, tid, lane, wave);
        STAMP(7); if (BOTH(3)) GRID_BAR(); STAMP(8);
    }
    if (IN(4)) {
        PH_SETUP
        const float* LSEG = (const float*)(ws + WS_LSEG); const float* ASEG = (const float*)(ws + WS_ASEG); const float* ng = A_->in[12];
        if (tid < 32) *(LAS f32x4*)(L + hg::HG_NGL + tid * 16) = *(const f32x4*)(ng + tid * 4);
        for (int j = wave * G + bx; j < BATCH * NHEAD * 16; j += NWAVES * G) { const int bh = j >> 4, nbkb = j & 15, kb = j & 3, hh = lane >> 5;
            float Ssc[16];
#pragma unroll
            for (int q = 0; q < 16; ++q) Ssc[q] = 0.f;
#pragma unroll
            for (int sg = 0; sg < 7; ++sg) { const int un = bh * 8 + sg; float* lp = (float*)LSEG + ((size_t)(un * 16 + nbkb) * 16) * 64 + lane; const float* ap = ASEG + un * 128 + 32 * kb + 4 * hh;
#pragma unroll
                for (int g = 0; g < 4; ++g) { const f32x4 a = *(const f32x4*)(ap + 8 * g);
#pragma unroll
                    for (int e = 0; e < 4; ++e) { Ssc[4 * g + e] = a[e] * Ssc[4 * g + e] + lp[(4 * g + e) * 64]; lp[(4 * g + e) * 64] = Ssc[4 * g + e]; } } } }
        GRID_BAR();
        for (int un = bx; un < BATCH * NHEAD * 8; un += G) hg::y_unit(L, un, QD, KI, V, GS, DEC, LSEG, YCAT, tid, lane, wave);
        STAMP(9); if (BOTH(4)) GRID_BAR(); STAMP(10);
    }
    if (IN(5)) {
        PH_SETUP
        pg8::Gemm g{YCAT, WOUT, M, D, D, 0, nullptr, 0}; pg8::StaticOrder S; S.init(M, D, G, bx);
        pg8::EpiE2 E{(bf16*)(ws + WS_Y2)};
        pg8::gemm_phase<pg8::EpiE2, pg8::StaticOrder, true, true, false>(L + RING_OFF, g, S, E);
        STAMP(11); if (BOTH(5)) GRID_BAR(); STAMP(12);
    }

    if (IN(6)) {
        PH_SETUP
        const float* brg = A_->in[17]; const float* bre = A_->in[19];
        gu32* cntw = ctl + CW_CNT;
#if defined(PROBE_SUB) && PROBE_SUB == 4
        if (lo == 6 && hi == 7) { TOKE = (int*)(ws + WS_LSEG); TOKW = (float*)(ws + WS_LSEG + 1 * MiB); TOKP = (int*)(ws + WS_LSEG + 2 * MiB); LIST = (int*)(ws + WS_LSEG + 4 * MiB); cntw = ctl + 2048; }
#endif
        typedef float f32x4r __attribute__((ext_vector_type(4)));
        { v4u wr_[12];
#pragma unroll
          for (int i = 0; i < 12; ++i) { const int q = tid + 512 * i, n = q >> 7, kc = q & 127; wr_[i] = *(const GAS v4u*)(WR + (size_t)n * D + kc * 8); }
#pragma unroll
          for (int i = 0; i < 12; ++i) { const int q = tid + 512 * i, n = q >> 7, kc = q & 127; *(LAS v4u*)(L + n * 2048 + ((kc ^ (n & 15)) << 4)) = wr_[i]; } }
        LAS float* LG = (LAS float*)(L + 98304);
        LAS unsigned* lcnt = (LAS unsigned*)(L + 98304 + 128 * 49 * 4);
        __syncthreads();
        const bf16* Y2 = (const bf16*)(ws + WS_Y2); bf16* X1B = (bf16*)(ws + WS_S);
        for (int blk = bx; blk < M / 128; blk += G) {
            if (tid < 64) lcnt[tid] = 0u;
            const int R0 = blk * 128 + 16 * wave;
            { const int bb = (blk * 128) / SEQ; const float* c1p = CV + bb * D; const float* c2p = CV + BATCH * D + bb * D; const float* c3p = CV + 2 * BATCH * D + bb * D;
              f32x4 c1[4], c2[4], c3[4];
#pragma unroll
              for (int j = 0; j < 4; ++j) { const int cc = 4 * lane + 256 * j; c1[j] = *(const f32x4*)(c1p + cc); c2[j] = *(const f32x4*)(c2p + cc); c3[j] = *(const f32x4*)(c3p + cc); }
#pragma unroll 1
              for (int r0 = 0; r0 < 16; r0 += 4) {
                  v2u yv[4][4]; f32x4 xv[4][4];
#pragma unroll
                  for (int q = 0; q < 4; ++q) { const size_t m = (size_t)(R0 + r0 + q);
#pragma unroll
                      for (int j = 0; j < 4; ++j) { const int cc = 4 * lane + 256 * j; yv[q][j] = *(const GAS v2u*)(Y2 + m * D + cc); xv[q][j] = *(const GAS f32x4*)(x + m * D + cc); } }
#pragma unroll
                  for (int q = 0; q < 4; ++q) { const size_t m = (size_t)(R0 + r0 + q);
                      f32x4 yf[4]; float s1 = 0.f;
#pragma unroll
                      for (int j = 0; j < 4; ++j) { const v2u a = yv[q][j]; yf[j] = (f32x4){__uint_as_float(a.x << 16), __uint_as_float(a.x & 0xffff0000u), __uint_as_float(a.y << 16), __uint_as_float(a.y & 0xffff0000u)};
                          s1 += (yf[j].x * yf[j].x + yf[j].y * yf[j].y) + (yf[j].z * yf[j].z + yf[j].w * yf[j].w); }
                      const float rs1 = 1.f / sqrtf(wave_sum(s1) * (1.f / D) + EPS);
                      f32x4 x1[4]; float s2 = 0.f;
#pragma unroll
                      for (int j = 0; j < 4; ++j) { x1[j] = xv[q][j] + c1[j] * (yf[j] * rs1); s2 += (x1[j].x * x1[j].x + x1[j].y * x1[j].y) + (x1[j].z * x1[j].z + x1[j].w * x1[j].w); }
                      const float rs2 = 1.f / sqrtf(wave_sum(s2) * (1.f / D) + EPS);
#pragma unroll
                      for (int j = 0; j < 4; ++j) { const int cc = 4 * lane + 256 * j; const f32x4 h = (x1[j] * rs2) * c2[j] + c3[j];
                          *(GAS v2u*)(X1B + m * D + cc) = (v2u){hg::cvtpk(x1[j].x, x1[j].y), hg::cvtpk(x1[j].z, x1[j].w)};
                          *(GAS v2u*)(HA + m * D + cc) = (v2u){hg::cvtpk(h.x, h.y), hg::cvtpk(h.z, h.w)}; } } }
              asm volatile("s_waitcnt vmcnt(0)" ::: "memory");
            }

            f32x4r acc0 = {0.f, 0.f, 0.f, 0.f}, acc1 = acc0, acc2 = acc0;
            const bf16* arow = HA + (size_t)(R0 + (lane & 15)) * D + 8 * (lane >> 4);
            const int nl = lane & 15, ql = lane >> 4;
            bf16x8 afr[32];
#pragma unroll
            for (int kb = 0; kb < 32; ++kb) afr[kb] = *(const GAS bf16x8*)(arow + kb * 32);
#pragma unroll
            for (int kb = 0; kb < 32; ++kb) {
                const bf16x8 a = afr[kb];
                const int kc = kb * 4 + ql;
                const bf16x8 b0 = *(const LAS bf16x8*)(L + (nl) * 2048 + ((kc ^ nl) << 4));
                const bf16x8 b1 = *(const LAS bf16x8*)(L + (16 + nl) * 2048 + ((kc ^ nl) << 4));
                const bf16x8 b2 = *(const LAS bf16x8*)(L + (32 + nl) * 2048 + ((kc ^ nl) << 4));
                acc0 = __builtin_amdgcn_mfma_f32_16x16x32_bf16(a, b0, acc0, 0, 0, 0);
                acc1 = __builtin_amdgcn_mfma_f32_16x16x32_bf16(a, b1, acc1, 0, 0, 0);
                acc2 = __builtin_amdgcn_mfma_f32_16x16x32_bf16(a, b2, acc2, 0, 0, 0);
            }
#pragma unroll
            for (int r = 0; r < 4; ++r) { const int row = 16 * wave + ql * 4 + r; LG[row * 49 + nl] = acc0[r]; LG[row * 49 + 16 + nl] = acc1[r]; LG[row * 49 + 32 + nl] = acc2[r]; }
            __syncthreads();
            int e0 = 0, e1 = 0; unsigned lp0 = 0, lp1 = 0; float w0 = 0.f, w1 = 0.f;
            if (tid < 128) {
                const LAS float* lg = LG + tid * 49;
                float gv = -1e30f; int gi = 0; float gl[4];
#pragma unroll
                for (int i = 0; i < 4; ++i) { gl[i] = lg[i] + brg[i]; if (gl[i] > gv) { gv = gl[i]; gi = i; } }
                float se = 0.f;
#pragma unroll
                for (int i = 0; i < 4; ++i) se += __expf(gl[i] - gv);
                const float gp = 1.f / se;
                float v0 = -1e30f, v1 = -1e30f; int i0 = 0, i1 = 0;
#pragma unroll
                for (int i = 0; i < 8; ++i) { const float el = lg[4 + gi * 8 + i] + bre[gi * 8 + i]; if (el > v0) { v1 = v0; i1 = i0; v0 = el; i0 = i; } else if (el > v1) { v1 = el; i1 = i; } }
                const float p1 = __expf(v1 - v0), ps = 1.f + p1;
                e0 = gi * 8 + i0; e1 = gi * 8 + i1; w0 = gp / ps; w1 = gp * p1 / ps;
                lp0 = atomicAdd((unsigned*)&lcnt[e0], 1u); lp1 = atomicAdd((unsigned*)&lcnt[e1], 1u);
            }
            __syncthreads();
            if (tid < 32) lcnt[32 + tid] = __hip_atomic_fetch_add((unsigned*)(cntw + tid), lcnt[tid], __ATOMIC_RELAXED, __HIP_MEMORY_SCOPE_AGENT);
            __syncthreads();
            if (tid < 128) { const int tok = blk * 128 + tid; const int q0 = (int)(lcnt[32 + e0] + lp0), q1 = (int)(lcnt[32 + e1] + lp1);
                TOKE[tok * 2] = e0; TOKE[tok * 2 + 1] = e1; TOKW[tok * 2] = w0; TOKW[tok * 2 + 1] = w1; TOKP[tok * 2] = q0; TOKP[tok * 2 + 1] = q1;
                LIST[e0 * LISTCAP + q0] = tok * 2; LIST[e1 * LISTCAP + q1] = tok * 2 + 1; }
            __syncthreads();
        }
        STAMP(13); if (BOTH(6)) GRID_BAR(); STAMP(14);
    }
    if (IN(7)) {
        PH_SETUP
        pg8::Gemm g{HA, WGU, 0, 512, D, (size_t)512 * D * 2, LIST, LISTCAP}; pg8::grouped_table((LAS int*)(L + 133120), (const unsigned*)(ctl + CW_CNT), tid); pg8::GroupedOrderPub S{{(const LAS int*)(L + 133120), 2, G, vcu}, (unsigned*)(ctl + CW_DONE)};
        pg8::EpiE1 E{HB};
        pg8::gemm_phase<pg8::EpiE1, pg8::GroupedOrderPub, true, true, true>(L + RING_OFF, g, S, E);
        __syncthreads(); if (tid == 0) __hip_atomic_fetch_add(ctl + CW_WGDONE, 1u, __ATOMIC_RELAXED, __HIP_MEMORY_SCOPE_AGENT);
        STAMP(15); STAMP(16);
    }
    if (IN(8)) {
        PH_SETUP
        pg8::Gemm g{HB, WD, 0, D, DEXP, (size_t)D * DEXP * 2, nullptr, 0}; if (tid == 0) { LAS unsigned* sl = (LAS unsigned*)(L + 133120 + 1024); sl[0] = __hip_atomic_fetch_add(ctl + CW_QUEUE, 1u, RLX_AGENT); sl[2] = 0u; }
        pg8::grouped_table((LAS int*)(L + 133120), (const unsigned*)(ctl + CW_CNT), tid); pg8::GroupedOrderDep S{{(const LAS int*)(L + 133120), 4, G, vcu}, (const unsigned*)(ctl + CW_DONE), 16u, (unsigned*)(ctl + CW_QUEUE), (LAS unsigned*)(L + 133120 + 1024), (const unsigned*)(ctl + CW_WGDONE), (unsigned)G};
        pg8::EpiE2 E{YB};
        pg8::gemm_phase<pg8::EpiE2, pg8::GroupedOrderDep, true, true, false>(L + RING_OFF, g, S, E);
        STAMP(17); if (BOTH(8)) GRID_BAR(); STAMP(18);
    }
    if (IN(9)) {
        PH_SETUP
        LAS int* sbase = (LAS int*)(L + 133120);
        pg8::grouped_table(sbase, (const unsigned*)(ctl + CW_CNT), tid);
        const float* C4 = CV + 3 * BATCH * D;
        for (int mb = gw; mb < M; mb += 64 * NGW) {
            const int ml = mb + lane * NGW; int s0l = 0, s1l = 0; float w0l = 0.f, w1l = 0.f;
            if (ml < M) { const int e0 = TOKE[2 * ml], e1 = TOKE[2 * ml + 1]; s0l = sbase[e0] * 256 + TOKP[2 * ml]; s1l = sbase[e1] * 256 + TOKP[2 * ml + 1]; w0l = TOKW[2 * ml]; w1l = TOKW[2 * ml + 1]; }
        for (int k0 = 0; k0 < 64 && mb + k0 * NGW < M; k0 += 4) {
            v4u ya[4][2], yc[4][2], xb[4][2]; float w0[4], w1[4]; int mrow[4];
#pragma unroll
            for (int q = 0; q < 4; ++q) { const int k = k0 + q; const bool live = mb + k * NGW < M; const int ks = live ? k : 0; const int m = mb + ks * NGW;
                mrow[q] = m;
                const size_t s0 = (size_t)__builtin_amdgcn_readlane(s0l, ks), s1 = (size_t)__builtin_amdgcn_readlane(s1l, ks);
                w0[q] = __uint_as_float(__builtin_amdgcn_readlane(__float_as_uint(w0l), ks)); w1[q] = __uint_as_float(__builtin_amdgcn_readlane(__float_as_uint(w1l), ks));
                const bf16* x1r = (const bf16*)(ws + WS_S) + (size_t)m * D;
#pragma unroll
                for (int j = 0; j < 2; ++j) { const int cc = 8 * lane + 512 * j; ya[q][j] = *(const GAS v4u*)(YB + s0 * D + cc); yc[q][j] = *(const GAS v4u*)(YB + s1 * D + cc); xb[q][j] = *(const GAS v4u*)(x1r + cc); } }
#pragma unroll
            for (int q = 0; q < 4; ++q) { const int m = mrow[q]; const int b = m / SEQ;
                float y[16]; float ss = 0.f;
#pragma unroll
                for (int j = 0; j < 2; ++j) { const unsigned aw[4] = {ya[q][j].x, ya[q][j].y, ya[q][j].z, ya[q][j].w}, cw[4] = {yc[q][j].x, yc[q][j].y, yc[q][j].z, yc[q][j].w};
#pragma unroll
                    for (int t = 0; t < 4; ++t) { const float lo = w0[q] * __uint_as_float(aw[t] << 16) + w1[q] * __uint_as_float(cw[t] << 16), hi = w0[q] * __uint_as_float(aw[t] & 0xffff0000u) + w1[q] * __uint_as_float(cw[t] & 0xffff0000u);
                        y[8 * j + 2 * t] = lo; y[8 * j + 2 * t + 1] = hi; ss += lo * lo + hi * hi; } }
                const float rstd = 1.f / sqrtf(wave_sum(ss) * (1.f / D) + EPS);
                float* orow = out + (size_t)m * D;
#pragma unroll
                for (int j = 0; j < 2; ++j) { const int cc = 8 * lane + 512 * j; const f32x4 c4a = *(const f32x4*)(C4 + b * D + cc), c4b = *(const f32x4*)(C4 + b * D + cc + 4); const v4u xv = xb[q][j];
                    const f32x4 xa = {__uint_as_float(xv.x << 16), __uint_as_float(xv.x & 0xffff0000u), __uint_as_float(xv.y << 16), __uint_as_float(xv.y & 0xffff0000u)};
                    const f32x4 xc = {__uint_as_float(xv.z << 16), __uint_as_float(xv.z & 0xffff0000u), __uint_as_float(xv.w << 16), __uint_as_float(xv.w & 0xffff0000u)};
                    const f32x4 ya4 = {y[8 * j], y[8 * j + 1], y[8 * j + 2], y[8 * j + 3]}, yb4 = {y[8 * j + 4], y[8 * j + 5], y[8 * j + 6], y[8 * j + 7]};
                    *(GAS f32x4*)(orow + cc) = xa + c4a * (ya4 * rstd); *(GAS f32x4*)(orow + cc + 4) = xc + c4b * (yb4 * rstd); } }
        }
        }
    }
#ifdef PROBE_T
    STAMP(19);
    if (bx == 0 && tid0 == 0) { volatile LAS unsigned long long* st = (volatile LAS unsigned long long*)(L + LDSCTL_OFF); const unsigned long long d = (unsigned long long)(PROBE_T_EXPR) * 8ull, t0 = __builtin_amdgcn_s_memrealtime();
        while (__builtin_amdgcn_s_memrealtime() - t0 < d) __builtin_amdgcn_s_sleep(8); }
#endif
#if defined(PROBE_SUB) && PROBE_SUB == 1
    if (IN(10)) { PH_SETUP const float* dw = A_->in[7]; const float* dwb = A_->in[8]; const float* lng = A_->in[9]; const float* lnb = A_->in[10];
        hg::conv_stage_w(L, dw, tid); { v4u rg[12]; if (bx < M / 64) hg::conv_tile_ld(rg, bx, U, tid); for (int cu = bx; cu < M / 64; cu += G) { __syncthreads(); hg::conv_tile_st(rg, L, tid); if (cu + G < M / 64) hg::conv_tile_ld(rg, cu + G, U, tid); __syncthreads(); hg::conv_unit(L, cu, dwb, lng, lnb, YCAT, tid, lane, wave); } } }
#elif defined(PROBE_SUB) && PROBE_SUB == 2
    if (IN(10)) { PH_SETUP float* LSEG = (float*)(ws + WS_LSEG); float* ASEG = (float*)(ws + WS_ASEG);
        for (int un = bx; un < BATCH * NHEAD * 8; un += G) hg::x_unit(L, un, KI, V, DEC, LSEG, ASEG, tid, lane, wave); }
#elif defined(PROBE_SUB) && PROBE_SUB == 3
    if (IN(10)) { for (int i = 0; i < 10; ++i) GRID_BAR(); }
#endif
#undef IN
#undef BOTH
}


extern "C" void kernel_launch(void* const* d_in, const int* in_sizes, int n_in, void* d_out, int out_size, void* d_ws, size_t ws_size, hipStream_t stream) {
    if (n_in != 23 || out_size != M * D || ws_size < WS_END) { fprintf(stderr, "kernel_launch: unexpected shapes n_in %d out %d ws %zu\n", n_in, out_size, ws_size); return; }
    static int grid = 0;
    if (grid == 0) {
        int dev = 0, cus = 0;
        if (hipGetDevice(&dev) != hipSuccess || hipDeviceGetAttribute(&cus, hipDeviceAttributeMultiprocessorCount, dev) != hipSuccess) { grid = -1; return; }
        if (hipFuncSetAttribute((const void*)fused_fwd, hipFuncAttributeMaxDynamicSharedMemorySize, LDS_BYTES) != hipSuccess) { fprintf(stderr, "hipFuncSetAttribute failed\n"); grid = -1; return; }
        grid = cus;
    }
    if (grid < 0) return;
    (void)hipMemsetAsync((char*)d_ws + WS_CTL, 0, 1 * MiB, stream);
    Args a{}; for (int i = 0; i < 23; ++i) a.in[i] = (const float*)d_in[i]; a.out = (float*)d_out; a.ws = (unsigned char*)d_ws;
#ifndef PROBE_PHASE
    a.ph_lo = 0; a.ph_hi = 10; a.bar_region = 0;
    hipLaunchKernelGGL(fused_fwd, dim3(grid), dim3(NWAVES * 64), LDS_BYTES, stream, a);
#else
#ifndef PROBE_SUB
#define PROBE_SUB 0
#endif
    a.ph_lo = 0; a.ph_hi = PROBE_PHASE + 1; a.bar_region = 0; hipLaunchKernelGGL(fused_fwd, dim3(grid), dim3(NWAVES * 64), LDS_BYTES, stream, a);
    if (PROBE_SUB >= 1 && PROBE_SUB <= 3) { a.ph_lo = 10; a.ph_hi = 11; } else { a.ph_lo = PROBE_PHASE; a.ph_hi = PROBE_PHASE + 1; }
    a.bar_region = 1; hipLaunchKernelGGL(fused_fwd, dim3(grid), dim3(NWAVES * 64), LDS_BYTES, stream, a);
    if (PROBE_PHASE < 9) { a.ph_lo = PROBE_PHASE + 1; a.ph_hi = 10; a.bar_region = 2; hipLaunchKernelGGL(fused_fwd, dim3(grid), dim3(NWAVES * 64), LDS_BYTES, stream, a); }
#endif
}
```

```cpp
#include <hip/hip_runtime.h>
#include <cstdio>
#include <cstdint>

typedef unsigned short bf16;
#define DI __device__ __forceinline__

constexpr int D = 1024, BATCH = 8, SEQ = 4096, M = BATCH * SEQ;
constexpr int DCONV = 512, DREC = 512, NHEAD = 4, DK = 128, DV = 128, CHUNK = 64, NCHUNK = M / CHUNK;
constexpr int DIN = 3072, CW = 31;
constexpr int NGRP = 4, EPG = 8, NEXP = 32, DEXP = 256;
constexpr float EPS = 1e-6f;
constexpr int LISTCAP = 32768;
constexpr int SLOTS = 2 * M + NEXP * 256;

constexpr size_t MiB = 1u << 20;
constexpr size_t WS_CTL = 0;
constexpr size_t WS_MOD = 1 * MiB;
constexpr size_t WS_LB = WS_MOD + 256 * 1024;
constexpr size_t WS_CV = WS_MOD + 512 * 1024;
constexpr size_t WS_WR = WS_MOD + 768 * 1024;
constexpr size_t WS_WIN = 456 * MiB;
constexpr size_t WS_WOUT = 462 * MiB;
constexpr size_t WS_WGU = 464 * MiB;
constexpr size_t WS_WD = 496 * MiB;
constexpr size_t WS_TOKE = 2 * MiB;
constexpr size_t WS_TOKW = WS_TOKE + 256 * 1024;
constexpr size_t WS_TOKP = WS_TOKW + 256 * 1024;
constexpr size_t WS_LIST = 4 * MiB;
constexpr size_t WS_LSEG = 8 * MiB;
constexpr size_t WS_ASEG = 24 * MiB;
constexpr size_t WS_DEC = 25 * MiB;
constexpr size_t WS_XB = 26 * MiB;
constexpr size_t WS_A = 392 * MiB;
constexpr size_t WS_B = 200 * MiB;
constexpr size_t WS_U = WS_B, WS_QD = WS_B + 32 * MiB, WS_KI = WS_B + 64 * MiB, WS_KE = WS_B + 96 * MiB, WS_V = WS_B + 128 * MiB, WS_GS = WS_B + 160 * MiB;
constexpr size_t WS_Y2 = WS_B;
constexpr size_t WS_HB = WS_B;
constexpr size_t WS_YB = WS_B + 36 * MiB;
constexpr size_t WS_C = 72 * MiB;
constexpr size_t WS_S = 136 * MiB;
constexpr size_t WS_END = 512 * MiB;

DI float bf2f(bf16 v) { return __uint_as_float((unsigned)v << 16); }
DI bf16 f2bf(float f) { unsigned u = __float_as_uint(f); return (bf16)((u + 0x7fffu + ((u >> 16) & 1u)) >> 16); }
DI float sigmoidf_(float x) { return 1.f / (1.f + __expf(-x)); }
DI float siluf_(float x) { return x / (1.f + __expf(-x)); }

__host__ __device__ inline int win_src_col(int n) {
    const int pn = n >> 8, half = (n >> 7) & 1, ch = n & 127;
    if (pn < 4) return (half ? 512 : 0) + 128 * pn + ch;
    if (pn < 8) return 1024 + (half ? 512 : 0) + 128 * (pn - 4) + ch;
    return 2048 + (half ? 512 : 0) + 128 * (pn - 8) + ch;
}


namespace pg8 {
#define PG8_LAS __attribute__((address_space(3)))
typedef unsigned short bf16_t;
typedef short bf16x8 __attribute__((ext_vector_type(8)));
typedef float f32x4 __attribute__((ext_vector_type(4)));
typedef unsigned u32x4 __attribute__((ext_vector_type(4)));
constexpr int BM = 256, BK = 64, HALF = 128, HTB = HALF * BK * 2  , STAGE_BYTES = 8 * HTB, NXCD = 8, WGM = 8;

__host__ __device__ __forceinline__ int lds_byte(int r, int c) { const int st = (r >> 4) * 2 + (c >> 5), rr = r & 15, cc = c & 31, ob = rr * 64 + cc * 2; return st * 1024 + (ob ^ (((ob >> 9) & 1) << 5)); }
__host__ __device__ __forceinline__ void stage_rc(int b, int& R, int& C) { const int st = b / 1024, sb = b % 1024, swz = sb ^ (((sb >> 9) & 1) << 5); R = (st >> 1) * 16 + swz / 64; C = (st & 1) * 32 + (swz % 64) / 2; }
__host__ __device__ __forceinline__ int perm32(int rho) { const int n = rho >> 4, i = rho & 15; return 8 * (i >> 2) + 4 * n + (i & 3); }

struct Unit { int pm, pn, e, r0, ne; };
struct Gemm { const bf16_t* A; const bf16_t* Bt; int M, N, K; size_t b_estride; const int* list; int listcap; };

struct StaticOrder {
    int nM, nN, nwg, G, c;
    __host__ __device__ void init(int M, int N, int G_, int c_) { nM = M / BM; nN = N / BM; nwg = nM * nN; G = G_; c = c_; }
    __host__ __device__ bool next(int i, Unit& u) const {
        const long L = (long)i * G + c; if (L >= nwg) return false;
        int wgid = (int)L; { const int q = nwg / NXCD, r = nwg % NXCD, xcd = wgid % NXCD, off = wgid / NXCD; wgid = (xcd < r ? xcd * (q + 1) : r * (q + 1) + (xcd - r) * q) + off; }
        const int nig = WGM * nN, gid = wgid / nig, fm = gid * WGM, gsz = (nM - fm) < WGM ? (nM - fm) : WGM;
        u.pm = fm + ((wgid % nig) % gsz); u.pn = (wgid % nig) / gsz; u.e = 0; u.r0 = 0; u.ne = 0; return true;
    }
    __device__ __forceinline__ void a_ready(const Unit&) const {}
    __device__ __forceinline__ void done(const Unit&) const {}
};


__device__ __forceinline__ unsigned cvt_pk_bf16(float lo, float hi) { unsigned r; asm volatile("v_cvt_pk_bf16_f32 %0, %1, %2" : "=v"(r) : "v"(lo), "v"(hi)); return r; }
typedef float f32x2 __attribute__((ext_vector_type(2)));

template <class Epi, class Sched, bool ALIGN_EPI = false, bool SP2 = false, bool GATHER = false>
__device__ __forceinline__ void gemm_phase(PG8_LAS unsigned char* lds, const Gemm g, const Sched& S, const Epi& E) {
    const int tid = threadIdx.x, wid = __builtin_amdgcn_readfirstlane(tid >> 6), lane = tid & 63, wr = wid >> 2, wc = wid & 3, fr = lane & 15, fq = lane >> 4;
    const int K = g.K, nt = K / BK;
    unsigned voffA[2], voffB[2]; unsigned voffAg[2][2];
#pragma unroll
    for (int i = 0; i < 2; ++i) { int R, C; stage_rc(tid * 16 + i * 8192, R, C); const int Rb = Epi::PERM ? ((R & ~31) + perm32(R & 31)) : R;
        voffA[i] = (unsigned)(R * K + C) * 2u; voffB[i] = (unsigned)(Rb * K + C) * 2u; }
    const size_t kstep = (size_t)(BK * 2);
    const size_t hstep = (size_t)HALF * K * 2;
    const size_t tstep = 2 * hstep;
    const unsigned ldsw = (unsigned)wid * 1024u;
    const int aoff = lds_byte(wr * 64 + fr, fq * 8), boff = lds_byte(wc * 32 + fr, fq * 8);
#define PG8_SA(b, h) (((b) * 2 + (h)) * HTB)
#define PG8_SB(b, h) ((4 + (b) * 2 + (h)) * HTB)
#define PG8_STAGE(bufoff, gbase, voff) do { _Pragma("unroll") for (int _i = 0; _i < 2; ++_i) \
        __builtin_amdgcn_global_load_lds((const unsigned*)((const char*)(gbase) + (voff)[_i]), (PG8_LAS unsigned*)(lds + (bufoff) + ldsw + _i * 8192), 16, 0, 0); } while (0)
#define PG8_STAGE_A(bufoff, gbase, h) do { if constexpr (GATHER) { PG8_STAGE(bufoff, gbase, voffAg[h]); } else { PG8_STAGE(bufoff, (gbase) + (h) * hstep, voffA); } } while (0)
#define PG8_GLOAD(dst, un) do { _Pragma("unroll") for (int _h = 0; _h < 2; ++_h) _Pragma("unroll") for (int _i = 0; _i < 2; ++_i) { int _R, _C; stage_rc(tid * 16 + _i * 8192, _R, _C); const int _pos = (un).r0 + 128 * _h + _R; \
        int _tok = 0; if (_pos < (un).ne) _tok = g.list[(size_t)(un).e * g.listcap + _pos] >> 1; dst[_h][_i] = (unsigned)(_tok * K + _C) * 2u; } } while (0)
#define PG8_GPREFETCH(un) do { if (wid == 0) __builtin_amdgcn_global_load_lds((const unsigned*)(g.list + (size_t)(un).e * g.listcap + (un).r0 + lane * 4), (PG8_LAS unsigned*)(lds + STAGE_BYTES + 1024), 16, 0, 0); } while (0)
#define PG8_GFROMLDS(dst, un) do { _Pragma("unroll") for (int _h = 0; _h < 2; ++_h) _Pragma("unroll") for (int _i = 0; _i < 2; ++_i) { int _R, _C; stage_rc(tid * 16 + _i * 8192, _R, _C); const int _p = 128 * _h + _R; \
        int _tok = ((const PG8_LAS int*)(lds + STAGE_BYTES + 1024))[_p] >> 1; if ((un).r0 + _p >= (un).ne) _tok = 0; dst[_h][_i] = (unsigned)(_tok * K + _C) * 2u; } } while (0)
#define PG8_GSWITCH do { if constexpr (GATHER) { if (last && has_next) { PG8_GFROMLDS(voffAg, nxt); } } } while (0)
#define PG8_LDA(dst, b, h) do { _Pragma("unroll") for (int m = 0; m < 4; ++m) _Pragma("unroll") for (int k = 0; k < 2; ++k) dst[m][k] = *(const PG8_LAS bf16x8*)(lds + PG8_SA(b, h) + aoff + m * 2048 + k * 1024); } while (0)
#define PG8_LDB(dst, b, h) do { _Pragma("unroll") for (int n = 0; n < 2; ++n) _Pragma("unroll") for (int k = 0; k < 2; ++k) dst[n][k] = *(const PG8_LAS bf16x8*)(lds + PG8_SB(b, h) + boff + n * 2048 + k * 1024); } while (0)
#define PG8_MMA(ai, bj, At, Bt) do { __builtin_amdgcn_s_setprio(1); _Pragma("unroll") for (int m = 0; m < 4; ++m) _Pragma("unroll") for (int n = 0; n < 2; ++n) _Pragma("unroll") for (int k = 0; k < 2; ++k) \
        acc[ai][bj][m][n] = __builtin_amdgcn_mfma_f32_16x16x32_bf16(Bt[n][k], At[m][k], acc[ai][bj][m][n], 0, 0, 0); __builtin_amdgcn_s_setprio(0); } while (0)
#define PG8_WAIT_V(n) asm volatile("s_waitcnt vmcnt(" #n ")" ::: "memory")
#define PG8_WAIT_L(n) asm volatile("s_waitcnt lgkmcnt(" #n ")" ::: "memory")
#define PG8_BAR __builtin_amdgcn_s_barrier()
#define PG8_SCHED __builtin_amdgcn_sched_barrier(0)
    Unit cur, nxt; int ui = 0; cur.e = 0;
    if (!S.next(0, cur)) return;
    f32x4 acc[2][2][4][2];
#pragma unroll
    for (int a = 0; a < 2; ++a)
#pragma unroll
        for (int b = 0; b < 2; ++b)
#pragma unroll
            for (int m = 0; m < 4; ++m)
#pragma unroll
                for (int n = 0; n < 2; ++n) acc[a][b][m][n] = (f32x4){0.f, 0.f, 0.f, 0.f};
    bf16x8 At[4][2], B0[2][2], B1[2][2];
    const char* cA = (const char*)g.A + (GATHER ? (size_t)0 : (size_t)cur.pm * tstep); const char* cB = (const char*)g.Bt + (size_t)cur.e * g.b_estride + (size_t)cur.pn * tstep;
    if constexpr (GATHER) { PG8_GLOAD(voffAg, cur); }
    S.a_ready(cur);
    if constexpr (SP2) {
        PG8_STAGE(PG8_SB(0, 0), cB, voffB); PG8_STAGE(PG8_SB(0, 1), cB + hstep, voffB); PG8_STAGE_A(PG8_SA(0, 0), cA, 0); PG8_STAGE_A(PG8_SA(0, 1), cA, 1);
        if (wr == 1) PG8_BAR;
        PG8_WAIT_V(2); PG8_BAR;
        PG8_STAGE(PG8_SB(1, 0), cB + kstep, voffB); PG8_STAGE_A(PG8_SA(1, 0), cA + kstep, 0); PG8_STAGE(PG8_SB(1, 1), cB + hstep + kstep, voffB);
        PG8_WAIT_V(6); PG8_BAR;
    } else {
        PG8_STAGE(PG8_SB(0, 0), cB, voffB); PG8_STAGE_A(PG8_SA(0, 0), cA, 0); PG8_STAGE(PG8_SB(0, 1), cB + hstep, voffB); PG8_STAGE_A(PG8_SA(0, 1), cA, 1);
        if (wr == 1) PG8_BAR;
        PG8_WAIT_V(4); PG8_BAR;
        PG8_STAGE(PG8_SB(1, 0), cB + kstep, voffB); PG8_STAGE_A(PG8_SA(1, 0), cA + kstep, 0); PG8_STAGE(PG8_SB(1, 1), cB + hstep + kstep, voffB);
        PG8_WAIT_V(6); PG8_BAR;
    }
    for (;;) {
        nxt.e = cur.e; const bool has_next = S.next(ui + 1, nxt);
        const char* nA = has_next ? (const char*)g.A + (GATHER ? (size_t)0 : (size_t)nxt.pm * tstep) : cA; const char* nB = has_next ? (const char*)g.Bt + (size_t)nxt.e * g.b_estride + (size_t)nxt.pn * tstep : cB;
        if constexpr (GATHER) { if (has_next) { PG8_GPREFETCH(nxt); } }
        for (int t = 0; t < nt; t += 2) {
            const bool last = (t == nt - 2);
            const char* a1 = cA + (size_t)(t + 1) * kstep;
            const char* a2 = last ? nA : cA + (size_t)(t + 2) * kstep; const char* b2 = last ? nB : cB + (size_t)(t + 2) * kstep;
            const char* a3 = a2 + kstep; const char* b3 = b2 + kstep;
            if (last && has_next) S.a_ready(nxt);
            if constexpr (SP2) {
            PG8_LDB(B0, 0, 0); PG8_LDB(B1, 0, 1); PG8_SCHED; PG8_LDA(At, 0, 0); PG8_STAGE_A(PG8_SA(1, 1), a1, 1); PG8_GSWITCH;
            PG8_WAIT_V(8); PG8_WAIT_L(0); PG8_BAR; PG8_MMA(0, 0, At, B0); PG8_MMA(0, 1, At, B1); PG8_BAR; PG8_SCHED;
            PG8_LDA(At, 0, 1); PG8_STAGE(PG8_SB(0, 0), b2, voffB); PG8_STAGE(PG8_SB(0, 1), b2 + hstep, voffB); PG8_STAGE_A(PG8_SA(0, 0), a2, 0);
            PG8_WAIT_V(8); PG8_WAIT_L(0); PG8_BAR; PG8_MMA(1, 0, At, B0); PG8_MMA(1, 1, At, B1); PG8_BAR; PG8_SCHED;
            PG8_LDB(B0, 1, 0); PG8_LDB(B1, 1, 1); PG8_SCHED; PG8_LDA(At, 1, 0); PG8_STAGE_A(PG8_SA(0, 1), a2, 1);
            PG8_WAIT_V(8); PG8_WAIT_L(0); PG8_BAR; PG8_MMA(0, 0, At, B0); PG8_MMA(0, 1, At, B1); PG8_BAR; PG8_SCHED;
            PG8_LDA(At, 1, 1); PG8_STAGE(PG8_SB(1, 0), b3, voffB); PG8_STAGE(PG8_SB(1, 1), b3 + hstep, voffB); PG8_STAGE_A(PG8_SA(1, 0), a3, 0);
            PG8_WAIT_V(8); PG8_WAIT_L(0); PG8_BAR; PG8_MMA(1, 0, At, B0); PG8_MMA(1, 1, At, B1); PG8_BAR; PG8_SCHED;
            } else {
            PG8_LDB(B0, 0, 0); PG8_SCHED; PG8_LDA(At, 0, 0); PG8_STAGE_A(PG8_SA(1, 1), a1, 1); PG8_GSWITCH;
            PG8_WAIT_L(8); PG8_BAR; PG8_WAIT_L(0); PG8_MMA(0, 0, At, B0); PG8_BAR; PG8_SCHED;
            PG8_LDB(B1, 0, 1); PG8_STAGE(PG8_SB(0, 0), b2, voffB);
            PG8_BAR; PG8_WAIT_L(0); PG8_MMA(0, 1, At, B1); PG8_BAR;
            PG8_LDA(At, 0, 1); PG8_STAGE_A(PG8_SA(0, 0), a2, 0);
            PG8_BAR; PG8_WAIT_L(0); PG8_MMA(1, 0, At, B0); PG8_BAR; PG8_SCHED;
            PG8_STAGE(PG8_SB(0, 1), b2 + hstep, voffB);
            PG8_WAIT_V(6); PG8_BAR; PG8_MMA(1, 1, At, B1); PG8_BAR;
            PG8_LDB(B0, 1, 0); PG8_SCHED; PG8_LDA(At, 1, 0); PG8_STAGE_A(PG8_SA(0, 1), a2, 1);
            PG8_WAIT_L(8); PG8_BAR; PG8_WAIT_L(0); PG8_MMA(0, 0, At, B0); PG8_BAR; PG8_SCHED;
            PG8_LDB(B1, 1, 1); PG8_STAGE(PG8_SB(1, 0), b3, voffB);
            PG8_BAR; PG8_WAIT_L(0); PG8_MMA(0, 1, At, B1); PG8_BAR;
            PG8_LDA(At, 1, 1); PG8_STAGE_A(PG8_SA(1, 0), a3, 0);
            PG8_BAR; PG8_WAIT_L(0); PG8_MMA(1, 0, At, B0); PG8_BAR; PG8_SCHED;
            PG8_STAGE(PG8_SB(1, 1), b3 + hstep, voffB);
            PG8_WAIT_V(6); PG8_BAR; PG8_MMA(1, 1, At, B1); PG8_BAR;
            }
        }
        if constexpr (ALIGN_EPI) { if (wr == 0) PG8_BAR; }
        if constexpr (!Epi::AFTER_DRAIN) { E(acc, cur, wr, wc, fr, fq); S.done(cur); }
        if (!has_next) break;
#pragma unroll
        for (int a = 0; a < 2; ++a)
#pragma unroll
            for (int b = 0; b < 2; ++b)
#pragma unroll
                for (int m = 0; m < 4; ++m)
#pragma unroll
                    for (int n = 0; n < 2; ++n) acc[a][b][m][n] = (f32x4){0.f, 0.f, 0.f, 0.f};
        cur = nxt; cA = nA; cB = nB; ++ui;
        if constexpr (ALIGN_EPI) { if (wr == 1) PG8_BAR; }
    }
    PG8_WAIT_V(0);
    if constexpr (!ALIGN_EPI) { if (wr == 0) PG8_BAR; }
    PG8_BAR;
    if constexpr (Epi::AFTER_DRAIN) { E.fused(acc, cur, wr, wc, fr, fq, lds, wid, lane); S.done(cur); }
#undef PG8_SA
#undef PG8_SB
#undef PG8_STAGE
#undef PG8_STAGE_A
#undef PG8_GLOAD
#undef PG8_GPREFETCH
#undef PG8_GFROMLDS
#undef PG8_GSWITCH
#undef PG8_LDA
#undef PG8_LDB
#undef PG8_MMA
#undef PG8_WAIT_V
#undef PG8_WAIT_L
#undef PG8_BAR
#undef PG8_SCHED
}
}


namespace pg8 {
__device__ __forceinline__ float rcp_(float x) { return __builtin_amdgcn_rcpf(x); }
__device__ __forceinline__ float sigm_(float x) { return rcp_(1.f + __expf(-x)); }
template <int N> __device__ __forceinline__ float dpp_shr(float x) { return __builtin_bit_cast(float, __builtin_amdgcn_update_dpp(0, __builtin_bit_cast(int, x), 0x110 + N, 0xf, 0xf, false)); }
__device__ __forceinline__ u32x4 pack8(const f32x4 a, const f32x4 b) { u32x4 w; w.x = cvt_pk_bf16(a[0], a[1]); w.y = cvt_pk_bf16(a[2], a[3]); w.z = cvt_pk_bf16(b[0], b[1]); w.w = cvt_pk_bf16(b[2], b[3]); return w; }

struct EpiG1 {
    static constexpr bool PERM = true, AFTER_DRAIN = false;
    bf16_t *U, *QD, *KI, *KE, *V, *GS; float* DEC; const float* lb;
    __device__ __forceinline__ void operator()(const f32x4 (&acc)[2][2][4][2], const Unit& u, int wr, int wc, int fr, int fq) const {
        const int kind = u.pn >> 2, j = u.pn & 3;
        const int row0 = u.pm * BM + wr * 64 + fr;
        const int oc = 128 * j + wc * 32 + 8 * fq;
        if (kind == 0) {
#pragma unroll
            for (int ai = 0; ai < 2; ++ai)
#pragma unroll
                for (int m = 0; m < 4; ++m) { const size_t o = (size_t)(row0 + ai * HALF + m * 16) * 512 + oc; f32x4 r0, r1;
#pragma unroll
                    for (int e = 0; e < 4; ++e) { r0[e] = acc[ai][0][m][0][e] * sigm_(acc[ai][1][m][0][e]); r1[e] = acc[ai][0][m][1][e] * sigm_(acc[ai][1][m][1][e]); }
                    *(u32x4*)(U + o) = pack8(r0, r1); asm volatile("" ::: "memory"); }
        } else if (kind == 2) {
#pragma unroll
            for (int ai = 0; ai < 2; ++ai)
#pragma unroll
                for (int m = 0; m < 4; ++m) { const size_t o = (size_t)(row0 + ai * HALF + m * 16) * 512 + oc; f32x4 r0, r1;
#pragma unroll
                    for (int e = 0; e < 4; ++e) { const float g0 = acc[ai][1][m][0][e], g1 = acc[ai][1][m][1][e]; r0[e] = g0 * sigm_(g0); r1[e] = g1 * sigm_(g1); }
                    *(u32x4*)(V + o) = pack8(acc[ai][0][m][0], acc[ai][0][m][1]); *(u32x4*)(GS + o) = pack8(r0, r1); asm volatile("" ::: "memory"); }
        } else {
            float oml[8];
            { const f32x4 l0 = *(const f32x4*)(lb + oc), l1 = *(const f32x4*)(lb + oc + 4);
#pragma unroll
              for (int e = 0; e < 4; ++e) { oml[e] = 1.f - l0[e]; oml[4 + e] = 1.f - l1[e]; } }
#pragma unroll
            for (int ai = 0; ai < 2; ++ai) {
                unsigned qpk[4][2], kpk[4][2];
#pragma unroll
                for (int hc = 0; hc < 2; ++hc) {
                    float kk[4][4], bb[4][4];
#pragma unroll
                    for (int m = 0; m < 4; ++m)
#pragma unroll
                        for (int c = 0; c < 4; ++c) { const float f = acc[ai][1][m][hc][c]; const float k = oml[4 * hc + c] * rcp_(1.f + __expf(f)); kk[m][c] = k; bb[m][c] = __logf(1.f - k); }
#pragma unroll
                    for (int m = 0; m < 4; ++m)
#pragma unroll
                        for (int c = 0; c < 4; ++c) { bb[m][c] += dpp_shr<1>(bb[m][c]); bb[m][c] += dpp_shr<2>(bb[m][c]); bb[m][c] += dpp_shr<4>(bb[m][c]); bb[m][c] += dpp_shr<8>(bb[m][c]); }
                    float bl[4];
#pragma unroll
                    for (int c = 0; c < 4; ++c) { const float t0 = __shfl(bb[0][c], 15, 16), t1 = __shfl(bb[1][c], 15, 16), t2 = __shfl(bb[2][c], 15, 16), t3 = __shfl(bb[3][c], 15, 16);
                        bb[1][c] += t0; bb[2][c] += t0 + t1; bb[3][c] += (t0 + t1) + t2; bl[c] = ((t0 + t1) + t2) + t3; }
#pragma unroll
                    for (int m = 0; m < 4; ++m) { float qd[4], ki[4];
#pragma unroll
                        for (int c = 0; c < 4; ++c) { const float q = acc[ai][0][m][hc][c]; const float eb = __expf(bb[m][c]); qd[c] = q * sigm_(q) * eb; ki[c] = kk[m][c] * rcp_(eb); }
                        const unsigned q01 = cvt_pk_bf16(qd[0], qd[1]), q23 = cvt_pk_bf16(qd[2], qd[3]), k01 = cvt_pk_bf16(ki[0], ki[1]), k23 = cvt_pk_bf16(ki[2], ki[3]);
                        if (hc == 0) { qpk[m][0] = q01; qpk[m][1] = q23; kpk[m][0] = k01; kpk[m][1] = k23; }
                        else { const size_t o = (size_t)(row0 + ai * HALF + m * 16) * 512 + oc;
                            *(u32x4*)(QD + o) = (u32x4){qpk[m][0], qpk[m][1], q01, q23}; *(u32x4*)(KI + o) = (u32x4){kpk[m][0], kpk[m][1], k01, k23}; asm volatile("" ::: "memory"); } }
                    if (fr == 0) { float* dp = DEC + (size_t)(4 * u.pm + 2 * ai + wr) * 512 + oc + 4 * hc; f32x4 d0;
#pragma unroll
                        for (int e = 0; e < 4; ++e) d0[e] = __expf(bl[e]);
                        *(f32x4*)dp = d0; }
                }
            }
        }
    }
};

struct EpiE1 {
    static constexpr bool PERM = true, AFTER_DRAIN = false;
    bf16_t* HB;
    __device__ __forceinline__ void operator()(const f32x4 (&acc)[2][2][4][2], const Unit& u, int wr, int wc, int fr, int fq) const {
        const int row0 = u.pm * BM + wr * 64 + fr, oc = 128 * u.pn + wc * 32 + 8 * fq;
#pragma unroll
        for (int ai = 0; ai < 2; ++ai)
#pragma unroll
            for (int m = 0; m < 4; ++m) { const size_t o = (size_t)(row0 + ai * HALF + m * 16) * 256 + oc; f32x4 r0, r1;
#pragma unroll
                for (int e = 0; e < 4; ++e) { const float g0 = acc[ai][0][m][0][e], g1 = acc[ai][0][m][1][e]; r0[e] = g0 * sigm_(g0) * acc[ai][1][m][0][e]; r1[e] = g1 * sigm_(g1) * acc[ai][1][m][1][e]; }
                { const u32x4 w = pack8(r0, r1); const bf16_t* p = HB + o; asm volatile("global_store_dwordx4 %0, %1, off sc1\n\ts_nop 1" :: "v"(p), "v"(w) : "memory"); }
            }
    }
};
struct EpiE2 {
    static constexpr bool PERM = true, AFTER_DRAIN = false;
    bf16_t* YB;
    __device__ __forceinline__ void operator()(const f32x4 (&acc)[2][2][4][2], const Unit& u, int wr, int wc, int fr, int fq) const {
        const int row0 = u.pm * BM + wr * 64 + fr, col0 = u.pn * BM + wc * 32 + 8 * fq;
#pragma unroll
        for (int ai = 0; ai < 2; ++ai)
#pragma unroll
            for (int m = 0; m < 4; ++m) { bf16_t* rowp = YB + (size_t)(row0 + ai * HALF + m * 16) * 1024 + col0;
#pragma unroll
                for (int bj = 0; bj < 2; ++bj) *(u32x4*)(rowp + bj * HALF) = pack8(acc[ai][bj][m][0], acc[ai][bj][m][1]);
                asm volatile("" ::: "memory"); }
    }
};
struct GroupedOrder {
    const PG8_LAS int* tab; int nN, G, c;
    __device__ bool next(int i, Unit& u) const {
        const long L = (long)i * G + c; const int T = (int)(L / nN), pn = (int)(L % nN);
        if (T >= tab[32]) return false;
        int e = u.e; if (e < 0 || e > 31) e = 0;
        while (e < 31 && T >= tab[e + 1]) ++e;
        u.pm = T; u.pn = pn; u.e = e; u.r0 = (T - tab[e]) * 256; u.ne = tab[64 + e]; return true;
    }
    __device__ __forceinline__ void a_ready(const Unit&) const {}
    __device__ __forceinline__ void done(const Unit&) const {}
};
struct GroupedOrderPub : GroupedOrder {
    unsigned* donecnt;
    __device__ __forceinline__ void done(const Unit& u) const {
        asm volatile("s_waitcnt vmcnt(0)" ::: "memory");
        if ((threadIdx.x & 63) == 0) __hip_atomic_fetch_add(donecnt + 64 * u.pm, 1u, __ATOMIC_RELAXED, __HIP_MEMORY_SCOPE_AGENT);
    }
};
struct GroupedOrderDep : GroupedOrder {
    const unsigned* ready; unsigned need; unsigned* queue; PG8_LAS unsigned* slot; const unsigned* wgdone; unsigned nwg;
    __device__ bool next(int i, Unit& u) const {
        const unsigned L = (unsigned)__builtin_amdgcn_readfirstlane(slot[i & 1]); const unsigned seen = (unsigned)__builtin_amdgcn_readfirstlane(slot[2]);
        unsigned nxt_ticket = 0u; if (threadIdx.x == 0) nxt_ticket = __hip_atomic_fetch_add(queue, 1u, __ATOMIC_RELAXED, __HIP_MEMORY_SCOPE_AGENT);
        const int T = (int)(L / (unsigned)nN), pn = (int)(L % (unsigned)nN);
        const bool ok = T < tab[32];
        if (ok) { int e = u.e; if (e < 0 || e > 31) e = 0;
            while (e < 31 && T >= tab[e + 1]) ++e;
            u.pm = T; u.pn = pn; u.e = e; u.r0 = (T - tab[e]) * 256; u.ne = tab[64 + e];
            if (seen == 0u && threadIdx.x < 64) {
                unsigned alld = 0u;
                if ((unsigned)__builtin_amdgcn_readfirstlane(__hip_atomic_load(wgdone, __ATOMIC_RELAXED, __HIP_MEMORY_SCOPE_AGENT)) >= nwg) alld = 1u;
                else { unsigned polls = 0;
                    while ((unsigned)__builtin_amdgcn_readfirstlane(__hip_atomic_load(ready + 64 * T, __ATOMIC_RELAXED, __HIP_MEMORY_SCOPE_AGENT)) < need) { __builtin_amdgcn_s_sleep(2); if (++polls > (1u << 20)) break; } }
                __builtin_amdgcn_fence(__ATOMIC_ACQUIRE, "agent");
                asm volatile("s_waitcnt vmcnt(0)" ::: "memory");
                if (alld && threadIdx.x == 0) slot[2] = 1u;
            } }
        if (threadIdx.x == 0) slot[(i + 1) & 1] = nxt_ticket;
        asm volatile("s_waitcnt lgkmcnt(0)" ::: "memory"); __builtin_amdgcn_s_barrier(); asm volatile("" ::: "memory");
        return ok;
    }
};
__device__ __forceinline__ void grouped_table(PG8_LAS int* tab, const unsigned* cnt, int tid) {
    if (tid < 32) { const int n = (int)__hip_atomic_load(cnt + tid, __ATOMIC_RELAXED, __HIP_MEMORY_SCOPE_AGENT); tab[64 + tid] = n; int nt = (n + 255) >> 8, incl = nt;
#pragma unroll
        for (int o = 1; o < 32; o <<= 1) { const int t = __shfl_up(incl, o, 32); if (tid >= o) incl += t; }
        tab[tid] = incl - nt; if (tid == 31) tab[32] = incl; }
    __syncthreads();
}
}

constexpr int NWAVES = 8;
constexpr int RING_OFF = 0, RING_BYTES = 131072;
constexpr int LDSCTL_OFF = RING_BYTES, MISC_OFF = LDSCTL_OFF + 320;
constexpr int LDS_BYTES = 147456;
constexpr int CW_CNT = 0;
constexpr int CW_TMO = 64, CW_CODE = 65;
constexpr int CW_BAR = 4096;
constexpr int CW_WGDONE = 3136;
constexpr int CW_QUEUE = 3072;
constexpr int CW_DONE = 40960;
constexpr int CW_SEAM = 16384, SEAM_BANK = 128 * 64;

#define GAS __attribute__((address_space(1)))
#define LAS __attribute__((address_space(3)))
typedef unsigned v4u __attribute__((ext_vector_type(4)));
typedef unsigned v2u __attribute__((ext_vector_type(2)));
typedef float f32x4 __attribute__((ext_vector_type(4)));
typedef short bf16x8 __attribute__((ext_vector_type(8)));
typedef GAS unsigned gu32;
typedef GAS unsigned long long gu64;
#define RLX_AGENT __ATOMIC_RELAXED, __HIP_MEMORY_SCOPE_AGENT
#define LDS_WAIT() asm volatile("s_waitcnt lgkmcnt(0)" ::: "memory")
#define VM_WAIT() asm volatile("s_waitcnt vmcnt(0)" ::: "memory")
__device__ __forceinline__ unsigned long long rt() { return __builtin_amdgcn_s_memrealtime(); }
__device__ __forceinline__ unsigned pk2(float lo, float hi) { return (unsigned)f2bf(lo) | ((unsigned)f2bf(hi) << 16); }

#define XB_TMO      128
#define XB_XCNT(j)  (256  + 64 * (j))
#define XB_XSUB(j)  (1280 + 64 * (j))
#define XB_XGEN(j)  (2304 + 64 * (j))
#define XB_TOP      3328
#define XB_TOPGEN   3392
#define XCD_BAR_WORDS 3456
#define XB_SPIN_CAP (1u << 18)

__device__ __forceinline__ unsigned xb_ld(unsigned* p)              { return __hip_atomic_load(p, __ATOMIC_RELAXED, __HIP_MEMORY_SCOPE_AGENT); }
__device__ __forceinline__ unsigned xb_add(unsigned* p, unsigned v) { return __hip_atomic_fetch_add(p, v, __ATOMIC_RELAXED, __HIP_MEMORY_SCOPE_AGENT); }
__device__ __forceinline__ unsigned xb_xcc_id() { return (unsigned)__builtin_amdgcn_s_getreg((3 << 11) | 20) & 0xFu; }
#define XB_SPIN(cond, bar) do { unsigned _sp = 0; while (cond) { __builtin_amdgcn_s_sleep(1); \
    if ((++_sp & 255u) == 0u) { if (xb_ld(&(bar)[XB_TMO])) break; if (_sp > XB_SPIN_CAP) { atomicAdd(&(bar)[XB_TMO], 1u); break; } } } } while (0)

struct XcdBarrier {
    unsigned* bar; unsigned x;
    volatile LAS unsigned* st;
};

__device__ __forceinline__ XcdBarrier xcd_barrier_post(unsigned* bar, volatile LAS unsigned* st) {
    XcdBarrier b; b.bar = bar; b.x = xb_xcc_id(); b.st = st;
    if (threadIdx.x == 0) (void)xb_add(&bar[XB_XCNT(b.x)], 1u);
    return b;
}
__device__ __forceinline__ void xcd_barrier_complete(unsigned* bar, unsigned x, unsigned& nloc, unsigned& nx) {
    const unsigned G = gridDim.x * gridDim.y * gridDim.z;
    unsigned sum, cnt, mine, sp = 0u;
    for (;;) {
        sum = 0u; cnt = 0u; mine = 0u;
#pragma unroll
        for (unsigned j = 0; j < 16; ++j) { const unsigned c = xb_ld(&bar[XB_XCNT(j)]); sum += c; cnt += (c > 0u) ? 1u : 0u; mine = (j == x) ? c : mine; }
        if (sum == G) break;
        __builtin_amdgcn_s_sleep(1);
        if ((++sp & 255u) == 0u) { if (xb_ld(&bar[XB_TMO])) break; if (sp > XB_SPIN_CAP) { atomicAdd(&bar[XB_TMO], 1u); break; } }
    }
    nloc = mine > 0u ? mine : 1u; nx = cnt > 0u ? cnt : 1u;
}

__device__ __forceinline__ void xcd_barrier(const XcdBarrier& b) {
    asm volatile("s_waitcnt vmcnt(0)" ::: "memory");
    __syncthreads();
    if (threadIdx.x == 0) {
        unsigned* bar = b.bar;
        __builtin_amdgcn_s_waitcnt(0);
        unsigned nloc = b.st[0], nx = b.st[1];
        if (nloc == 0u) { xcd_barrier_complete(bar, b.x, nloc, nx); b.st[0] = nloc; b.st[1] = nx; }
        const unsigned old = xb_add(&bar[XB_XSUB(b.x)], 1u);
        const unsigned gen = old / nloc;
        if (old + 1u == (gen + 1u) * nloc) {
            __builtin_amdgcn_fence(__ATOMIC_RELEASE, "agent");
            asm volatile("s_waitcnt vmcnt(0)" ::: "memory");
            const unsigned og = xb_add(&bar[XB_TOP], 1u);
            const unsigned tg = og / nx;
            if (og + 1u == (tg + 1u) * nx) xb_add(&bar[XB_TOPGEN], 1u);
            else XB_SPIN(xb_ld(&bar[XB_TOPGEN]) == tg, bar);
            __builtin_amdgcn_fence(__ATOMIC_ACQUIRE, "agent");
            xb_add(&bar[XB_XGEN(b.x)], 1u);
            asm volatile("s_waitcnt vmcnt(0)" ::: "memory");
        } else {
            XB_SPIN(xb_ld(&bar[XB_XGEN(b.x)]) == gen, bar);
            __builtin_amdgcn_fence(__ATOMIC_ACQUIRE, "agent");
            asm volatile("s_waitcnt vmcnt(0)" ::: "memory");
        }
    }
    __syncthreads();
}


namespace hg {
typedef short s16x4 __attribute__((ext_vector_type(4)));
typedef short v4i16_t __attribute__((ext_vector_type(4)));
typedef float f32x16 __attribute__((ext_vector_type(16)));
typedef float f32x2_t __attribute__((ext_vector_type(2)));
typedef __bf16 bf16x2_t __attribute__((ext_vector_type(2)));
typedef LAS const char* lcp;
DI unsigned cvtpk(float lo, float hi) { f32x2_t v = {lo, hi}; bf16x2_t b = __builtin_convertvector(v, bf16x2_t); return __builtin_bit_cast(unsigned, b); }
DI unsigned off_b(unsigned row, unsigned ch) { return 256u * row + 16u * (ch ^ (((row & 3) << 2) | ((row >> 2) & 3))); }
DI int crow(int reg, int h) { return (reg & 3) + 8 * (reg >> 2) + 4 * h; }
DI s16x4 trrd(lcp p) { return __builtin_bit_cast(s16x4, __builtin_amdgcn_ds_read_tr16_b64_v4i16((LAS v4i16_t*)p)); }
DI bf16x8 cat(s16x4 lo, s16x4 hi) { return __builtin_shufflevector(lo, hi, 0, 1, 2, 3, 4, 5, 6, 7); }
DI unsigned tr_addr(int lane, int rb, int c) { const unsigned blk = (lane >> 4) & 1, q = (lane & 15) >> 2, p = lane & 3; return off_b(rb + q, 4 * c + 2 * blk + (p >> 1)) + 8 * (p & 1); }
template <int S> DI bf16x8 pack_step(const f32x16& x) { v4u p; p.x = cvtpk(x[8 * S], x[8 * S + 1]); p.y = cvtpk(x[8 * S + 2], x[8 * S + 3]); p.z = cvtpk(x[8 * S + 4], x[8 * S + 5]); p.w = cvtpk(x[8 * S + 6], x[8 * S + 7]); return __builtin_bit_cast(bf16x8, p); }
#define HG_MFMA(a, b, c) __builtin_amdgcn_mfma_f32_32x32x16_bf16((a), (b), (c), 0, 0, 0)

template <int AUX = 0> DI void tile_dma(const bf16* base, LAS unsigned char* img, int wave, int lane) {
#pragma unroll
    for (int i = 0; i < 2; ++i) { const int p = wave * 2 + i, row = 4 * p + (lane >> 4), ch = (lane & 15) ^ (((row & 3) << 2) | ((row >> 2) & 3));
        __builtin_amdgcn_global_load_lds((const unsigned*)(base + (size_t)row * 512 + ch * 8), (LAS unsigned*)(img + p * 1024), 16, 0, AUX); }
}
constexpr int HG_DL = 133120, HG_NGL = 137216;

DI void x_unit(LAS unsigned char* L, int unit, const bf16* KI, const bf16* V, const float* DEC, float* LSEG, float* ASEG, int tid, int lane, int wave) {
    const int b = unit >> 5, h = (unit >> 3) & 3, seg = unit & 7;
    const int kbh = wave >> 2, nb = wave & 3, hh = lane >> 5;
    const size_t row0 = (size_t)b * SEQ + (size_t)seg * 512; const int c0 = (int)(row0 / CHUNK);
    LAS float* DL = (LAS float*)(L + HG_DL);
    f32x16 S2[2];
#pragma unroll
    for (int i = 0; i < 2; ++i)
#pragma unroll
        for (int r = 0; r < 16; ++r) S2[i][r] = 0.f;
    __syncthreads();
    if (tid < 256) { const int n = tid >> 5, c4 = (tid & 31) * 4; *(LAS f32x4*)(DL + n * 128 + c4) = *(const f32x4*)(DEC + (size_t)(c0 + n) * 512 + h * 128 + c4); }
#define HG_XDMA(n_) do { const size_t rn_ = row0 + (size_t)(n_) * CHUNK; LAS unsigned char* sl_ = L + ((n_) & 3) * 32768; tile_dma(KI + rn_ * 512 + h * 128, sl_, wave, lane); tile_dma(V + rn_ * 512 + h * 128, sl_ + 16384, wave, lane); } while (0)
    HG_XDMA(0); HG_XDMA(1); HG_XDMA(2);
    for (int n = 0; n < 8; ++n) {
        LAS unsigned char* KIi = L + (n & 3) * 32768; LAS unsigned char* Vi = KIi + 16384;
        if (n < 6) asm volatile("s_waitcnt vmcnt(8)" ::: "memory"); else if (n == 6) asm volatile("s_waitcnt vmcnt(4)" ::: "memory"); else asm volatile("s_waitcnt vmcnt(0)" ::: "memory");
        asm volatile("s_waitcnt lgkmcnt(0)" ::: "memory"); __builtin_amdgcn_s_barrier(); asm volatile("" ::: "memory");
        if (n + 3 < 8) HG_XDMA(n + 3);
#pragma unroll
        for (int ks = 0; ks < 4; ++ks) {
            const bf16x8 bv = cat(trrd((lcp)Vi + tr_addr(lane, 16 * ks + 8 * hh, nb)), trrd((lcp)Vi + tr_addr(lane, 16 * ks + 8 * hh + 4, nb)));
#pragma unroll
            for (int i = 0; i < 2; ++i) { const int kb = 2 * kbh + i;
                const bf16x8 a = cat(trrd((lcp)KIi + tr_addr(lane, 16 * ks + 8 * hh, kb)), trrd((lcp)KIi + tr_addr(lane, 16 * ks + 8 * hh + 4, kb)));
                S2[i] = HG_MFMA(a, bv, S2[i]); }
        }
#pragma unroll
        for (int i = 0; i < 2; ++i)
#pragma unroll
            for (int g = 0; g < 4; ++g) { const f32x4 d = *(const LAS f32x4*)(DL + n * 128 + 32 * (2 * kbh + i) + 8 * g + 4 * hh);
#pragma unroll
                for (int e = 0; e < 4; ++e) S2[i][4 * g + e] *= d[e]; }
    }
#pragma unroll
    for (int i = 0; i < 2; ++i) { const int kb = 2 * kbh + i; float* lp = LSEG + ((((size_t)unit * 4 + nb) * 4 + kb) * 16) * 64 + lane;
#pragma unroll
        for (int r = 0; r < 16; ++r) lp[r * 64] = S2[i][r]; }
    if (tid < 128) { float a = 1.f;
#pragma unroll
        for (int n = 0; n < 8; ++n) a *= DL[n * 128 + tid];
        ASEG[unit * 128 + tid] = a; }
#undef HG_XDMA
}

DI void y_unit(LAS unsigned char* L, int unit, const bf16* QD, const bf16* KI, const bf16* V, const bf16* GS, const float* DEC, const float* LSEG,
               bf16* YCAT, int tid, int lane, int wave) {
    const int b = unit >> 5, h = (unit >> 3) & 3, seg = unit & 7;
    const int cb = wave >> 2, nb = wave & 3, r = lane & 31, hh = lane >> 5;
    const size_t row0 = (size_t)b * SEQ + (size_t)seg * 512; const int c0 = (int)(row0 / CHUNK);
    LAS float* OST = (LAS float*)(L + 98304);
    LAS float* DL = (LAS float*)(L + HG_DL); LAS float* NGL = (LAS float*)(L + HG_NGL);
    __syncthreads();
    if (tid < 256) { const int n = tid >> 5, c4 = (tid & 31) * 4; *(LAS f32x4*)(DL + n * 128 + c4) = *(const f32x4*)(DEC + (size_t)(c0 + n) * 512 + h * 128 + c4); }
    { const size_t o = row0 * 512 + h * 128; tile_dma<2>(QD + o, L, wave, lane); tile_dma<2>(KI + o, L + 16384, wave, lane); tile_dma<2>(V + o, L + 32768, wave, lane); }
    f32x16 S[4];
#pragma unroll
    for (int kb = 0; kb < 4; ++kb)
#pragma unroll
        for (int q = 0; q < 16; ++q) S[kb][q] = 0.f;
    if (seg > 0) { const float* lp = LSEG + (((size_t)(unit - 1) * 4 + nb) * 4) * 16 * 64 + lane;
#pragma unroll
        for (int kb = 0; kb < 4; ++kb)
#pragma unroll
            for (int q = 0; q < 16; ++q) S[kb][q] = lp[(kb * 16 + q) * 64]; }
    const int ec = tid >> 3, edv = (tid & 7) * 16;
    for (int n = 0; n < 8; ++n) {
        LAS unsigned char* QDi = L + (n & 1) * 49152; LAS unsigned char* KIi = QDi + 16384; LAS unsigned char* Vi = QDi + 32768;
        __syncthreads();
        const size_t grow = row0 + (size_t)n * CHUNK + ec;
        const v4u g0 = __builtin_nontemporal_load((const GAS v4u*)(GS + grow * 512 + h * 128 + edv)), g1 = __builtin_nontemporal_load((const GAS v4u*)(GS + grow * 512 + h * 128 + edv + 8));
        if (n + 1 < 8) { const size_t o = (row0 + (size_t)(n + 1) * CHUNK) * 512 + h * 128; LAS unsigned char* nx = L + ((n + 1) & 1) * 49152;
            tile_dma<2>(QD + o, nx, wave, lane); tile_dma<2>(KI + o, nx + 16384, wave, lane); tile_dma<2>(V + o, nx + 32768, wave, lane); }
        f32x16 pt0, pt1;
#pragma unroll
        for (int q = 0; q < 16; ++q) { pt0[q] = 0.f; pt1[q] = 0.f; }
#pragma unroll
        for (int ks = 0; ks < 8; ++ks) {
            const bf16x8 bq = *(const LAS bf16x8*)(QDi + off_b(32 * cb + r, 2 * ks + hh));
            const bf16x8 a0 = *(const LAS bf16x8*)(KIi + off_b(r, 2 * ks + hh));
            pt0 = HG_MFMA(a0, bq, pt0);
            if (cb == 1) { const bf16x8 a1 = *(const LAS bf16x8*)(KIi + off_b(32 + r, 2 * ks + hh)); pt1 = HG_MFMA(a1, bq, pt1); }
        }
        if (cb == 0) {
#pragma unroll
            for (int q = 0; q < 16; ++q) if (crow(q, hh) > r) pt0[q] = 0.f;
        } else {
#pragma unroll
            for (int q = 0; q < 16; ++q) if (crow(q, hh) > r) pt1[q] = 0.f;
        }
        f32x16 O;
#pragma unroll
        for (int q = 0; q < 16; ++q) O[q] = 0.f;
        { const bf16x8 x0 = pack_step<0>(pt0), x1 = pack_step<1>(pt0);
          const bf16x8 v0 = cat(trrd((lcp)Vi + tr_addr(lane, 0 + 4 * hh, nb)), trrd((lcp)Vi + tr_addr(lane, 8 + 4 * hh, nb)));
          const bf16x8 v1 = cat(trrd((lcp)Vi + tr_addr(lane, 16 + 4 * hh, nb)), trrd((lcp)Vi + tr_addr(lane, 24 + 4 * hh, nb)));
          O = HG_MFMA(x0, v0, O); O = HG_MFMA(x1, v1, O); }
        if (cb == 1) { const bf16x8 x0 = pack_step<0>(pt1), x1 = pack_step<1>(pt1);
          const bf16x8 v0 = cat(trrd((lcp)Vi + tr_addr(lane, 32 + 4 * hh, nb)), trrd((lcp)Vi + tr_addr(lane, 40 + 4 * hh, nb)));
          const bf16x8 v1 = cat(trrd((lcp)Vi + tr_addr(lane, 48 + 4 * hh, nb)), trrd((lcp)Vi + tr_addr(lane, 56 + 4 * hh, nb)));
          O = HG_MFMA(x0, v0, O); O = HG_MFMA(x1, v1, O); }
#pragma unroll
        for (int kb = 0; kb < 4; ++kb) {
            const bf16x8 xb0 = pack_step<0>(S[kb]), xb1 = pack_step<1>(S[kb]);
            const unsigned o0 = off_b(32 * cb + r, 4 * kb) + 8 * hh, o1 = off_b(32 * cb + r, 4 * kb + 1) + 8 * hh, o2 = off_b(32 * cb + r, 4 * kb + 2) + 8 * hh, o3 = off_b(32 * cb + r, 4 * kb + 3) + 8 * hh;
            const bf16x8 qa0 = cat(*(const LAS s16x4*)(QDi + o0), *(const LAS s16x4*)(QDi + o1));
            const bf16x8 qa1 = cat(*(const LAS s16x4*)(QDi + o2), *(const LAS s16x4*)(QDi + o3));
            O = HG_MFMA(qa0, xb0, O); O = HG_MFMA(qa1, xb1, O);
        }
        if (n + 1 < 8) {
#pragma unroll
            for (int ks = 0; ks < 4; ++ks) {
                const bf16x8 bv = cat(trrd((lcp)Vi + tr_addr(lane, 16 * ks + 8 * hh, nb)), trrd((lcp)Vi + tr_addr(lane, 16 * ks + 8 * hh + 4, nb)));
#pragma unroll
                for (int kb = 0; kb < 4; ++kb) {
                    const bf16x8 a = cat(trrd((lcp)KIi + tr_addr(lane, 16 * ks + 8 * hh, kb)), trrd((lcp)KIi + tr_addr(lane, 16 * ks + 8 * hh + 4, kb)));
                    S[kb] = HG_MFMA(a, bv, S[kb]); }
            }
#pragma unroll
            for (int kb = 0; kb < 4; ++kb)
#pragma unroll
                for (int g = 0; g < 4; ++g) { const f32x4 d = *(const LAS f32x4*)(DL + n * 128 + 32 * kb + 8 * g + 4 * hh);
#pragma unroll
                    for (int e = 0; e < 4; ++e) S[kb][4 * g + e] *= d[e]; }
        }
#pragma unroll
        for (int q = 0; q < 16; ++q) OST[(32 * cb + crow(q, hh)) * 128 + 32 * nb + r] = O[q];
        asm volatile("s_waitcnt lgkmcnt(0)" ::: "memory"); __builtin_amdgcn_s_barrier(); asm volatile("" ::: "memory");
        { f32x4 o4[4]; float ss = 0.f;
#pragma unroll
          for (int i = 0; i < 4; ++i) { o4[i] = *(const LAS f32x4*)(OST + ec * 128 + edv + 4 * i); ss += (o4[i].x * o4[i].x + o4[i].y * o4[i].y) + (o4[i].z * o4[i].z + o4[i].w * o4[i].w); }
          ss += __shfl_xor(ss, 1); ss += __shfl_xor(ss, 2); ss += __shfl_xor(ss, 4);
          const float rstd = 1.f / sqrtf(ss * (1.f / DV) + EPS);
          const unsigned gw_[8] = {g0.x, g0.y, g0.z, g0.w, g1.x, g1.y, g1.z, g1.w};
          unsigned ow[8];
#pragma unroll
          for (int i = 0; i < 4; ++i) { const f32x4 gn = *(const LAS f32x4*)(NGL + edv + 4 * i);
              const float a0 = o4[i].x * rstd * gn.x * __uint_as_float(gw_[2 * i] << 16), a1 = o4[i].y * rstd * gn.y * __uint_as_float(gw_[2 * i] & 0xffff0000u);
              const float a2 = o4[i].z * rstd * gn.z * __uint_as_float(gw_[2 * i + 1] << 16), a3 = o4[i].w * rstd * gn.w * __uint_as_float(gw_[2 * i + 1] & 0xffff0000u);
              ow[2 * i] = cvtpk(a0, a1); ow[2 * i + 1] = cvtpk(a2, a3); }
          bf16* yp = YCAT + grow * D + 512 + h * 128 + edv;
          *(GAS v4u*)yp = (v4u){ow[0], ow[1], ow[2], ow[3]}; *(GAS v4u*)(yp + 8) = (v4u){ow[4], ow[5], ow[6], ow[7]}; }
    }
}

DI void conv_stage_w(LAS unsigned char* L, const float* dw, int tid) {
    LAS unsigned short* WT = (LAS unsigned short*)(L + 96256);
    float wv[CW];
#pragma unroll
    for (int j = 0; j < CW; ++j) wv[j] = dw[j * DCONV + tid];
#pragma unroll
    for (int j = 0; j < CW; ++j) WT[j * DCONV + tid] = f2bf(wv[j]);
}
DI void conv_tile_ld(v4u (&rg)[12], int cu, const bf16* U, int tid) {
    const size_t t0 = (size_t)cu * 64; const int trel = (int)(t0 % SEQ);
#pragma unroll
    for (int i = 0; i < 12; ++i) { const int q = tid + 512 * i, row = q >> 6, ch = q & 63; rg[i] = (v4u){0u, 0u, 0u, 0u};
        if (q < 94 * 64 && trel - 30 + row >= 0) rg[i] = __builtin_nontemporal_load((const GAS v4u*)(U + (t0 + row - 30) * 512 + ch * 8)); }
}
DI void conv_tile_st(const v4u (&rg)[12], LAS unsigned char* L, int tid) {
#pragma unroll
    for (int i = 0; i < 12; ++i) { const int q = tid + 512 * i, row = q >> 6, ch = q & 63; if (q < 94 * 64) *(LAS v4u*)(L + row * 1024 + ch * 16) = rg[i]; }
}
DI void conv_unit(LAS unsigned char* L, int cu, const float* dwb, const float* lng, const float* lnb, bf16* YCAT, int tid, int lane, int wave) {
    const size_t t0 = (size_t)cu * 64;
#pragma unroll 1
    for (int pass = 0; pass < 2; ++pass) {
        const int rbase = 8 * wave + 4 * pass;
        float acc[4][8];
        { const f32x4 b0 = *(const f32x4*)(dwb + 8 * lane), b1 = *(const f32x4*)(dwb + 8 * lane + 4);
#pragma unroll
          for (int rr = 0; rr < 4; ++rr) { acc[rr][0] = b0.x; acc[rr][1] = b0.y; acc[rr][2] = b0.z; acc[rr][3] = b0.w; acc[rr][4] = b1.x; acc[rr][5] = b1.y; acc[rr][6] = b1.z; acc[rr][7] = b1.w; } }
        float wA[8], wB[8], wC[8], wD[8];
#pragma unroll
        for (int c = 0; c < 8; ++c) { wA[c] = 0.f; wB[c] = 0.f; wC[c] = 0.f; wD[c] = 0.f; }
        LAS const unsigned char* up = L + rbase * 1024 + lane * 16; LAS const unsigned char* wp = L + 96256 + lane * 16;
#define CV_UNPK(dst, v) do { dst[0] = __uint_as_float((v).x << 16); dst[1] = __uint_as_float((v).x & 0xffff0000u); dst[2] = __uint_as_float((v).y << 16); dst[3] = __uint_as_float((v).y & 0xffff0000u); \
        dst[4] = __uint_as_float((v).z << 16); dst[5] = __uint_as_float((v).z & 0xffff0000u); dst[6] = __uint_as_float((v).w << 16); dst[7] = __uint_as_float((v).w & 0xffff0000u); } while (0)
#define CV_STEP(i, W0, W1, W2, W3) do { v4u w4 = {0u, 0u, 0u, 0u}; if ((i) <= 30) w4 = *(const LAS v4u*)(wp + (i) * 1024); CV_UNPK(W0, w4); \
        const v4u u4 = *(const LAS v4u*)(up + (i) * 1024); float u[8]; CV_UNPK(u, u4); \
        _Pragma("unroll") for (int c = 0; c < 8; ++c) { acc[0][c] += W0[c] * u[c]; acc[1][c] += W1[c] * u[c]; acc[2][c] += W2[c] * u[c]; acc[3][c] += W3[c] * u[c]; } } while (0)
#pragma unroll 1
        for (int ib = 0; ib < 9; ++ib) { const int i0 = 4 * ib;
            CV_STEP(i0, wA, wD, wC, wB); CV_STEP(i0 + 1, wB, wA, wD, wC); CV_STEP(i0 + 2, wC, wB, wA, wD); CV_STEP(i0 + 3, wD, wC, wB, wA); }
#undef CV_STEP
#undef CV_UNPK
        const f32x4 lg0 = *(const f32x4*)(lng + 8 * lane), lg1 = *(const f32x4*)(lng + 8 * lane + 4), lb0 = *(const f32x4*)(lnb + 8 * lane), lb1 = *(const f32x4*)(lnb + 8 * lane + 4);
        const float lgv[8] = {lg0.x, lg0.y, lg0.z, lg0.w, lg1.x, lg1.y, lg1.z, lg1.w}, lbv[8] = {lb0.x, lb0.y, lb0.z, lb0.w, lb1.x, lb1.y, lb1.z, lb1.w};
#pragma unroll
        for (int rr = 0; rr < 4; ++rr) {
            float s1 = 0.f, s2 = 0.f;
#pragma unroll
            for (int c = 0; c < 8; ++c) { s1 += acc[rr][c]; s2 += acc[rr][c] * acc[rr][c]; }
#pragma unroll
            for (int o = 1; o < 64; o <<= 1) { s1 += __shfl_xor(s1, o); s2 += __shfl_xor(s2, o); }
            const float mu = s1 * (1.f / DCONV), var = fmaxf(s2 * (1.f / DCONV) - mu * mu, 0.f), rstd = 1.f / sqrtf(var + EPS);
            float y[8];
#pragma unroll
            for (int c = 0; c < 8; ++c) { const float z = (acc[rr][c] - mu) * rstd * lgv[c] + lbv[c]; y[c] = z * pg8::sigm_(z); }
            *(GAS v4u*)(YCAT + (t0 + rbase + rr) * D + 8 * lane) = (v4u){cvtpk(y[0], y[1]), cvtpk(y[2], y[3]), cvtpk(y[4], y[5]), cvtpk(y[6], y[7])};
        }
    }
}
}

struct Args { const float* in[23]; float* out; unsigned char* ws; int ph_lo, ph_hi, bar_region, pad; };

__device__ __forceinline__ float wave_sum(float v) {
#pragma unroll
    for (int o = 1; o < 64; o <<= 1) v += __shfl_xor(v, o);
    return v;
}
struct TrItem { const float* src; bf16* dst; int ldsrc, srccol0, k0, lddst, dstrow0; };
__device__ __forceinline__ void tr_ld(float (&tv)[32], const TrItem& t, int lane) {
#pragma unroll
    for (int i = 0; i < 32; ++i) { const int kk = 2 * i + (lane >> 5); tv[i] = __builtin_nontemporal_load(t.src + (size_t)(t.k0 + kk) * t.ldsrc + t.srccol0 + (lane & 31)); }
}
__device__ __forceinline__ void tr_st(const float (&tv)[32], const TrItem& t, LAS float* scr, int lane) {
#pragma unroll
    for (int i = 0; i < 32; ++i) { const int kk = 2 * i + (lane >> 5); scr[kk * 33 + (lane & 31)] = tv[i]; }
    LDS_WAIT(); asm volatile("" ::: "memory");
    const int c = lane & 7;
#pragma unroll
    for (int j = 0; j < 4; ++j) { const int n = (lane >> 3) + 8 * j; const LAS float* s = scr + (8 * c) * 33 + n;
        v4u o; o.x = hg::cvtpk(s[0 * 33], s[1 * 33]); o.y = hg::cvtpk(s[2 * 33], s[3 * 33]); o.z = hg::cvtpk(s[4 * 33], s[5 * 33]); o.w = hg::cvtpk(s[6 * 33], s[7 * 33]);
        *(GAS v4u*)(t.dst + (size_t)(t.dstrow0 + n) * t.lddst + t.k0 + 8 * c) = o; }
    LDS_WAIT(); asm volatile("" ::: "memory");
}

__global__ void __launch_bounds__(NWAVES * 64, 2) fused_fwd(Args args) {
    extern __shared__ __attribute__((aligned(16))) unsigned char lds[];
    LAS unsigned char* L = (LAS unsigned char*)lds;
    volatile LAS unsigned* MISC = (volatile LAS unsigned*)(L + MISC_OFF);
    const int tid0 = threadIdx.x, wave = __builtin_amdgcn_readfirstlane(tid0 >> 6);
    const int G = gridDim.x, bx = blockIdx.x;
    const int vcu = (G % 8 == 0) ? (bx % 8) * (G / 8) + bx / 8 : bx;
    typedef const __attribute__((address_space(4))) Args* kargp;
#define KARGS() ({ kargp p_ = (kargp)__builtin_amdgcn_kernarg_segment_ptr(); asm volatile("" : "+s"(p_)); p_; })
#define PH_SETUP int tid = threadIdx.x; asm volatile("" : "+v"(tid)); const int lane = tid & 63; (void)lane; kargp A_ = KARGS(); unsigned char* ws = A_->ws; gu32* ctl = (gu32*)(ws + WS_CTL); const float* x = A_->in[0]; float* out = A_->out; \
    float* MOD = (float*)(ws + WS_MOD); float* LB = (float*)(ws + WS_LB); float* CV = (float*)(ws + WS_CV); \
    bf16 *WIN = (bf16*)(ws + WS_WIN), *WOUT = (bf16*)(ws + WS_WOUT), *WGU = (bf16*)(ws + WS_WGU), *WD = (bf16*)(ws + WS_WD), *WR = (bf16*)(ws + WS_WR); \
    bf16 *HA = (bf16*)(ws + WS_A), *U = (bf16*)(ws + WS_U), *QD = (bf16*)(ws + WS_QD), *KI = (bf16*)(ws + WS_KI), *KE = (bf16*)(ws + WS_KE), *V = (bf16*)(ws + WS_V), *GS = (bf16*)(ws + WS_GS); \
    bf16 *HB = (bf16*)(ws + WS_HB), *YB = (bf16*)(ws + WS_YB), *YCAT = (bf16*)(ws + WS_C); float* DEC = (float*)(ws + WS_DEC); \
    int* TOKE = (int*)(ws + WS_TOKE); float* TOKW = (float*)(ws + WS_TOKW); int* TOKP = (int*)(ws + WS_TOKP); int* LIST = (int*)(ws + WS_LIST); \
    (void)x; (void)out; (void)MOD; (void)LB; (void)CV; (void)WIN; (void)WOUT; (void)WGU; (void)WD; (void)WR; (void)HA; (void)U; (void)QD; (void)KI; (void)KE; (void)V; (void)GS; (void)HB; (void)YB; (void)YCAT; (void)DEC; (void)TOKE; (void)TOKW; (void)TOKP; (void)LIST; (void)ctl;
    for (int u = tid0; u < (LDS_BYTES - LDSCTL_OFF) / 4; u += NWAVES * 64) ((LAS unsigned*)(L + LDSCTL_OFF))[u] = 0u;
    __syncthreads();
    XcdBarrier bar = xcd_barrier_post((unsigned*)((gu32*)(args.ws + WS_CTL) + CW_BAR) + args.bar_region * XCD_BAR_WORDS, MISC + 8);
    const int lo = args.ph_lo, hi = args.ph_hi;
#ifdef PROBE_T
#define STAMP(i) do { if (tid0 == 0) ((volatile LAS unsigned long long*)(L + LDSCTL_OFF))[i] = __builtin_amdgcn_s_memrealtime(); } while (0)
#else
#define STAMP(i) do { } while (0)
#endif
    STAMP(0);
#ifndef PH_ENABLE
#define PH_ENABLE 0x3FF
#endif
#define IN(k) ((((k) >= 10) || ((PH_ENABLE >> (k)) & 1)) && lo <= (k) && (k) < hi)
#define BOTH(k) (IN(k) && IN((k) + 1))
#define GRID_BAR() xcd_barrier(bar)
    const int gw = vcu * NWAVES + wave, NGW = G * NWAVES;

    if (IN(0)) {
        PH_SETUP
        const float* c = A_->in[1]; const float* w_ada = A_->in[2]; const float* b_ada = A_->in[3];
        const float* w_in = A_->in[6]; const float* w_out = A_->in[13]; const float* w_gate = A_->in[20]; const float* w_up = A_->in[21]; const float* w_down = A_->in[22];
        if (bx < 192) {
            LAS float* sc = (LAS float*)(L);
            LAS float* red = (LAS float*)(L + 32768);
            for (int i = tid; i < BATCH * D; i += 512) { const float v = c[i]; sc[i] = v / (1.f + __expf(-v)); }
            __syncthreads();
            const int col = tid & 31, kg = tid >> 5, n0 = bx * 32;
            float a8[BATCH];
#pragma unroll
            for (int b = 0; b < BATCH; ++b) a8[b] = 0.f;
#pragma unroll 1
            for (int k0 = 0; k0 < 64; k0 += 16) { float wv[16];
#pragma unroll
                for (int kk = 0; kk < 16; ++kk) wv[kk] = __builtin_nontemporal_load(w_ada + (size_t)(kg * 64 + k0 + kk) * (6 * D) + n0 + col);
#pragma unroll
                for (int kk = 0; kk < 16; ++kk) { const int k = kg * 64 + k0 + kk;
#pragma unroll
                    for (int b = 0; b < BATCH; ++b) a8[b] += sc[b * D + k] * wv[kk]; } }
#pragma unroll
            for (int b = 0; b < BATCH; ++b) red[(kg * BATCH + b) * 32 + col] = a8[b];
            __syncthreads();
            if (tid < 256) { const int b = tid >> 5, cc = tid & 31; float s = 0.f;
#pragma unroll
                for (int k2 = 0; k2 < 16; ++k2) s += red[(k2 * BATCH + b) * 32 + cc];
                MOD[b * 6 * D + n0 + cc] = s + b_ada[n0 + cc]; }
            __syncthreads();
        } else if (bx == 192) {
            const float* lbl = A_->in[11];
            { const float a = lbl[tid], b = lbl[DREC + tid], m = fmaxf(a, b); const float ea = __expf(a - m), eb = __expf(b - m); LB[tid] = ea / (ea + eb); }
        }
        { const float* wrg = A_->in[16]; const float* wre = A_->in[18];
          for (int i = bx * 512 + tid; i < 48 * D; i += G * 512) { const int n = i / D, k = i % D; float v = 0.f; if (n < 4) v = wrg[k * 4 + n]; else if (n < 36) v = wre[k * 32 + (n - 4)]; WR[i] = (bf16)f2bf(v); } }
        LAS float* scr = (LAS float*)(L + RING_OFF + wave * 16384);
        constexpr int I_IN = 16 * 96, I_OUT = 16 * 32, I_GU = NEXP * 16 * 16, I_D = NEXP * 4 * 32;
        constexpr int NIT = I_IN + I_OUT + I_GU + I_D;
        auto decode = [&](int it) -> TrItem { int r = it; TrItem t;
            if (r < I_IN) { const int kb = r / 96, nb = r % 96; t = TrItem{w_in, WIN, DIN, win_src_col(32 * nb), 64 * kb, D, 32 * nb}; return t; } r -= I_IN;
            if (r < I_OUT) { const int kb = r / 32, nb = r % 32; t = TrItem{w_out, WOUT, D, 32 * nb, 64 * kb, D, 32 * nb}; return t; } r -= I_OUT;
            if (r < I_GU) { const int e = r / 256, kb = (r % 256) / 16, nb = r % 16; const int n = 32 * nb, pn = n >> 8, half = (n >> 7) & 1, ch = 128 * pn + (n & 127);
                t = TrItem{(half ? w_up : w_gate) + (size_t)e * D * DEXP, WGU + (size_t)e * 512 * D, DEXP, ch, 64 * kb, D, n}; return t; } r -= I_GU;
            { const int e = r / 128, kb = (r % 128) / 32, nb = r % 32; t = TrItem{w_down + (size_t)e * DEXP * D, WD + (size_t)e * D * DEXP, D, 32 * nb, 64 * kb, DEXP, 32 * nb}; return t; } };
        const bool split = (G == 256); const int NA = split ? 6 * NGW : NIT; const int xw = (bx - 192) * NWAVES + wave;
        auto item = [&](int j) -> int { if (j < NA / NGW || !split) { const int it = j * NGW + gw; return it < NA || !split ? (it < NIT ? it : -1) : -1; }
                                         if (bx < 192) return -1; const int it = NA + (j - NA / NGW) * 512 + xw; return it < NIT ? it : -1; };
        { int j = 0; TrItem ta, tb; float va[32], vb[32];
          int it = item(0); if (it >= 0) { ta = decode(it); tr_ld(va, ta, lane); }
          while (it >= 0) {
              const int it2 = item(j + 1); if (it2 >= 0) { tb = decode(it2); tr_ld(vb, tb, lane); }
              tr_st(va, ta, scr, lane);
              if (it2 < 0) break;
              const int it3 = item(j + 2); if (it3 >= 0) { ta = decode(it3); tr_ld(va, ta, lane); }
              tr_st(vb, tb, scr, lane);
              it = it3; j += 2; } }
        STAMP(1); if (BOTH(0)) GRID_BAR(); STAMP(2);
    }
    if (IN(1)) {
        PH_SETUP
        const float* g1 = A_->in[4]; const float* gpost = A_->in[5]; const float* gpre = A_->in[14]; const float* gpostf = A_->in[15];
        for (int i = bx * 512 + tid; i < BATCH * D; i += G * 512) { const int b = i / D, cc = i % D; const float* mb = MOD + b * 6 * D;
            CV[i] = mb[2 * D + cc] * gpost[cc]; CV[BATCH * D + i] = gpre[cc] * (1.f + mb[4 * D + cc]); CV[2 * BATCH * D + i] = mb[3 * D + cc]; CV[3 * BATCH * D + i] = mb[5 * D + cc] * gpostf[cc]; }
        auto p1_ld = [&](f32x4 (&v)[4][4], int m0) {
#pragma unroll
            for (int q = 0; q < 4; ++q) { int m = m0 + q * NGW; if (m >= M) m = m0;
                const GAS f32x4* xr = (const GAS f32x4*)(x + (size_t)m * D) + lane;
#pragma unroll
                for (int j = 0; j < 4; ++j) v[q][j] = __builtin_nontemporal_load(xr + 64 * j); } };
        auto p1_do = [&](const f32x4 (&v)[4][4], int m0) {
#pragma unroll
            for (int q = 0; q < 4; ++q) { int m = m0 + q * NGW; if (m >= M) m = m0; const int b = m / SEQ; const float* mb = MOD + b * 6 * D; float s = 0.f;
#pragma unroll
                for (int j = 0; j < 4; ++j) s += (v[q][j].x * v[q][j].x + v[q][j].y * v[q][j].y) + (v[q][j].z * v[q][j].z + v[q][j].w * v[q][j].w);
                const float rstd = 1.f / sqrtf(wave_sum(s) * (1.f / D) + EPS);
                GAS unsigned long long* o8 = (GAS unsigned long long*)(HA + (size_t)m * D) + lane;
#pragma unroll
                for (int j = 0; j < 4; ++j) { const int cc = 4 * lane + 256 * j; const f32x4 gg = *(const f32x4*)(g1 + cc), sc = *(const f32x4*)(mb + D + cc), sh = *(const f32x4*)(mb + cc);
                    const f32x4 o = (v[q][j] * rstd) * (gg * (sc + 1.f)) + sh;
                    o8[64 * j] = (unsigned long long)hg::cvtpk(o.x, o.y) | ((unsigned long long)hg::cvtpk(o.z, o.w) << 32); } } };
        { f32x4 va[4][4], vb[4][4]; int m0 = gw;
          if (m0 < M) p1_ld(va, m0);
          while (m0 < M) {
              const int m1 = m0 + 4 * NGW; if (m1 < M) p1_ld(vb, m1);
              p1_do(va, m0);
              m0 = m1; if (m0 >= M) break;
              const int m2 = m0 + 4 * NGW; if (m2 < M) p1_ld(va, m2);
              p1_do(vb, m0);
              m0 = m2; } }
        STAMP(3); if (BOTH(1)) GRID_BAR(); STAMP(4);
    }
    if (IN(2)) {
        PH_SETUP
        pg8::Gemm g{HA, WIN, M, DIN, D, 0, nullptr, 0}; pg8::StaticOrder S; S.init(M, DIN, G, bx);
        pg8::EpiG1 E{U, QD, KI, KE, V, GS, DEC, LB};
        pg8::gemm_phase<pg8::EpiG1, pg8::StaticOrder, true, true, false>(L + RING_OFF, g, S, E);
        STAMP(5); if (BOTH(2)) GRID_BAR(); STAMP(6);
    }
    if (IN(3)) {
        PH_SETUP
        const float* dw = A_->in[7]; const float* dwb = A_->in[8]; const float* lng = A_->in[9]; const float* lnb = A_->in[10];
        float* LSEG = (float*)(ws + WS_LSEG); float* ASEG = (float*)(ws + WS_ASEG);
        hg::conv_stage_w(L, dw, tid);
        { v4u rg[12]; if (bx < M / 64) hg::conv_tile_ld(rg, bx, U, tid);
          for (int cu = bx; cu < M / 64; cu += G) {
              __syncthreads();
              hg::conv_tile_st(rg, L, tid);
              if (cu + G < M / 64) hg::conv_tile_ld(rg, cu + G, U, tid);
              __syncthreads();
              hg::conv_unit(L, cu, dwb, lng, lnb, YCAT, tid, lane, wave); } }
        for (int un = bx; un < BATCH * NHEAD * 8; un += G) hg::x_unit(L, un, KI, V, DEC, LSEG, ASEG, tid, lane, wave);
        STAMP(7); if (BOTH(3)) GRID_BAR(); STAMP(8);
    }
    if (IN(4)) {
        PH_SETUP
        const float* LSEG = (const float*)(ws + WS_LSEG); const float* ASEG = (const float*)(ws + WS_ASEG); const float* ng = A_->in[12];
        if (tid < 32) *(LAS f32x4*)(L + hg::HG_NGL + tid * 16) = *(const f32x4*)(ng + tid * 4);
        for (int j = wave * G + bx; j < BATCH * NHEAD * 16; j += NWAVES * G) { const int bh = j >> 4, nbkb = j & 15, kb = j & 3, hh = lane >> 5;
            float Ssc[16];
#pragma unroll
            for (int q = 0; q < 16; ++q) Ssc[q] = 0.f;
#pragma unroll
            for (int sg = 0; sg < 7; ++sg) { const int un = bh * 8 + sg; float* lp = (float*)LSEG + ((size_t)(un * 16 + nbkb) * 16) * 64 + lane; const float* ap = ASEG + un * 128 + 32 * kb + 4 * hh;
#pragma unroll
                for (int g = 0; g < 4; ++g) { const f32x4 a = *(const f32x4*)(ap + 8 * g);
#pragma unroll
                    for (int e = 0; e < 4; ++e) { Ssc[4 * g + e] = a[e] * Ssc[4 * g + e] + lp[(4 * g + e) * 64]; lp[(4 * g + e) * 64] = Ssc[4 * g + e]; } } } }
        GRID_BAR();
        for (int un = bx; un < BATCH * NHEAD * 8; un += G) hg::y_unit(L, un, QD, KI, V, GS, DEC, LSEG, YCAT, tid, lane, wave);
        STAMP(9); if (BOTH(4)) GRID_BAR(); STAMP(10);
    }
    if (IN(5)) {
        PH_SETUP
        pg8::Gemm g{YCAT, WOUT, M, D, D, 0, nullptr, 0}; pg8::StaticOrder S; S.init(M, D, G, bx);
        pg8::EpiE2 E{(bf16*)(ws + WS_Y2)};
        pg8::gemm_phase<pg8::EpiE2, pg8::StaticOrder, true, true, false>(L + RING_OFF, g, S, E);
        STAMP(11); if (BOTH(5)) GRID_BAR(); STAMP(12);
    }

    if (IN(6)) {
        PH_SETUP
        const float* brg = A_->in[17]; const float* bre = A_->in[19];
        gu32* cntw = ctl + CW_CNT;
#if defined(PROBE_SUB) && PROBE_SUB == 4
        if (lo == 6 && hi == 7) { TOKE = (int*)(ws + WS_LSEG); TOKW = (float*)(ws + WS_LSEG + 1 * MiB); TOKP = (int*)(ws + WS_LSEG + 2 * MiB); LIST = (int*)(ws + WS_LSEG + 4 * MiB); cntw = ctl + 2048; }
#endif
        typedef float f32x4r __attribute__((ext_vector_type(4)));
        { v4u wr_[12];
#pragma unroll
          for (int i = 0; i < 12; ++i) { const int q = tid + 512 * i, n = q >> 7, kc = q & 127; wr_[i] = *(const GAS v4u*)(WR + (size_t)n * D + kc * 8); }
#pragma unroll
          for (int i = 0; i < 12; ++i) { const int q = tid + 512 * i, n = q >> 7, kc = q & 127; *(LAS v4u*)(L + n * 2048 + ((kc ^ (n & 15)) << 4)) = wr_[i]; } }
        LAS float* LG = (LAS float*)(L + 98304);
        LAS unsigned* lcnt = (LAS unsigned*)(L + 98304 + 128 * 49 * 4);
        __syncthreads();
        const bf16* Y2 = (const bf16*)(ws + WS_Y2); bf16* X1B = (bf16*)(ws + WS_S);
        for (int blk = bx; blk < M / 128; blk += G) {
            if (tid < 64) lcnt[tid] = 0u;
            const int R0 = blk * 128 + 16 * wave;
            { const int bb = (blk * 128) / SEQ; const float* c1p = CV + bb * D; const float* c2p = CV + BATCH * D + bb * D; const float* c3p = CV + 2 * BATCH * D + bb * D;
              f32x4 c1[4], c2[4], c3[4];
#pragma unroll
              for (int j = 0; j < 4; ++j) { const int cc = 4 * lane + 256 * j; c1[j] = *(const f32x4*)(c1p + cc); c2[j] = *(const f32x4*)(c2p + cc); c3[j] = *(const f32x4*)(c3p + cc); }
#pragma unroll 1
              for (int r0 = 0; r0 < 16; r0 += 4) {
                  v2u yv[4][4]; f32x4 xv[4][4];
#pragma unroll
                  for (int q = 0; q < 4; ++q) { const size_t m = (size_t)(R0 + r0 + q);
#pragma unroll
                      for (int j = 0; j < 4; ++j) { const int cc = 4 * lane + 256 * j; yv[q][j] = __builtin_nontemporal_load((const GAS v2u*)(Y2 + m * D + cc)); xv[q][j] = __builtin_nontemporal_load((const GAS f32x4*)(x + m * D + cc)); } }
#pragma unroll
                  for (int q = 0; q < 4; ++q) { const size_t m = (size_t)(R0 + r0 + q);
                      f32x4 yf[4]; float s1 = 0.f;
#pragma unroll
                      for (int j = 0; j < 4; ++j) { const v2u a = yv[q][j]; yf[j] = (f32x4){__uint_as_float(a.x << 16), __uint_as_float(a.x & 0xffff0000u), __uint_as_float(a.y << 16), __uint_as_float(a.y & 0xffff0000u)};
                          s1 += (yf[j].x * yf[j].x + yf[j].y * yf[j].y) + (yf[j].z * yf[j].z + yf[j].w * yf[j].w); }
                      const float rs1 = 1.f / sqrtf(wave_sum(s1) * (1.f / D) + EPS);
                      f32x4 x1[4]; float s2 = 0.f;
#pragma unroll
                      for (int j = 0; j < 4; ++j) { x1[j] = xv[q][j] + c1[j] * (yf[j] * rs1); s2 += (x1[j].x * x1[j].x + x1[j].y * x1[j].y) + (x1[j].z * x1[j].z + x1[j].w * x1[j].w); }
                      const float rs2 = 1.f / sqrtf(wave_sum(s2) * (1.f / D) + EPS);
#pragma unroll
                      for (int j = 0; j < 4; ++j) { const int cc = 4 * lane + 256 * j; const f32x4 h = (x1[j] * rs2) * c2[j] + c3[j];
                          *(GAS v2u*)(X1B + m * D + cc) = (v2u){hg::cvtpk(x1[j].x, x1[j].y), hg::cvtpk(x1[j].z, x1[j].w)};
                          *(GAS v2u*)(HA + m * D + cc) = (v2u){hg::cvtpk(h.x, h.y), hg::cvtpk(h.z, h.w)}; } } }
              asm volatile("s_waitcnt vmcnt(0)" ::: "memory");
            }

            f32x4r acc0 = {0.f, 0.f, 0.f, 0.f}, acc1 = acc0, acc2 = acc0;
            const bf16* arow = HA + (size_t)(R0 + (lane & 15)) * D + 8 * (lane >> 4);
            const int nl = lane & 15, ql = lane >> 4;
            bf16x8 afr[32];
#pragma unroll
            for (int kb = 0; kb < 32; ++kb) afr[kb] = *(const GAS bf16x8*)(arow + kb * 32);
#pragma unroll
            for (int kb = 0; kb < 32; ++kb) {
                const bf16x8 a = afr[kb];
                const int kc = kb * 4 + ql;
                const bf16x8 b0 = *(const LAS bf16x8*)(L + (nl) * 2048 + ((kc ^ nl) << 4));
                const bf16x8 b1 = *(const LAS bf16x8*)(L + (16 + nl) * 2048 + ((kc ^ nl) << 4));
                const bf16x8 b2 = *(const LAS bf16x8*)(L + (32 + nl) * 2048 + ((kc ^ nl) << 4));
                acc0 = __builtin_amdgcn_mfma_f32_16x16x32_bf16(a, b0, acc0, 0, 0, 0);
                acc1 = __builtin_amdgcn_mfma_f32_16x16x32_bf16(a, b1, acc1, 0, 0, 0);
                acc2 = __builtin_amdgcn_mfma_f32_16x16x32_bf16(a, b2, acc2, 0, 0, 0);
            }
#pragma unroll
            for (int r = 0; r < 4; ++r) { const int row = 16 * wave + ql * 4 + r; LG[row * 49 + nl] = acc0[r]; LG[row * 49 + 16 + nl] = acc1[r]; LG[row * 49 + 32 + nl] = acc2[r]; }
            __syncthreads();
            int e0 = 0, e1 = 0; unsigned lp0 = 0, lp1 = 0; float w0 = 0.f, w1 = 0.f;
            if (tid < 128) {
                const LAS float* lg = LG + tid * 49;
                float gv = -1e30f; int gi = 0; float gl[4];
#pragma unroll
                for (int i = 0; i < 4; ++i) { gl[i] = lg[i] + brg[i]; if (gl[i] > gv) { gv = gl[i]; gi = i; } }
                float se = 0.f;
#pragma unroll
                for (int i = 0; i < 4; ++i) se += __expf(gl[i] - gv);
                const float gp = 1.f / se;
                float v0 = -1e30f, v1 = -1e30f; int i0 = 0, i1 = 0;
#pragma unroll
                for (int i = 0; i < 8; ++i) { const float el = lg[4 + gi * 8 + i] + bre[gi * 8 + i]; if (el > v0) { v1 = v0; i1 = i0; v0 = el; i0 = i; } else if (el > v1) { v1 = el; i1 = i; } }
                const float p1 = __expf(v1 - v0), ps = 1.f + p1;
                e0 = gi * 8 + i0; e1 = gi * 8 + i1; w0 = gp / ps; w1 = gp * p1 / ps;
                lp0 = atomicAdd((unsigned*)&lcnt[e0], 1u); lp1 = atomicAdd((unsigned*)&lcnt[e1], 1u);
            }
            __syncthreads();
            if (tid < 32) lcnt[32 + tid] = __hip_atomic_fetch_add((unsigned*)(cntw + tid), lcnt[tid], __ATOMIC_RELAXED, __HIP_MEMORY_SCOPE_AGENT);
            __syncthreads();
            if (tid < 128) { const int tok = blk * 128 + tid; const int q0 = (int)(lcnt[32 + e0] + lp0), q1 = (int)(lcnt[32 + e1] + lp1);
                TOKE[tok * 2] = e0; TOKE[tok * 2 + 1] = e1; TOKW[tok * 2] = w0; TOKW[tok * 2 + 1] = w1; TOKP[tok * 2] = q0; TOKP[tok * 2 + 1] = q1;
                LIST[e0 * LISTCAP + q0] = tok * 2; LIST[e1 * LISTCAP + q1] = tok * 2 + 1; }
            __syncthreads();
        }
        STAMP(13); if (BOTH(6)) GRID_BAR(); STAMP(14);
    }
    if (IN(7)) {
        PH_SETUP
        pg8::Gemm g{HA, WGU, 0, 512, D, (size_t)512 * D * 2, LIST, LISTCAP}; pg8::grouped_table((LAS int*)(L + 133120), (const unsigned*)(ctl + CW_CNT), tid); pg8::GroupedOrderPub S{{(const LAS int*)(L + 133120), 2, G, vcu}, (unsigned*)(ctl + CW_DONE)};
        pg8::EpiE1 E{HB};
        pg8::gemm_phase<pg8::EpiE1, pg8::GroupedOrderPub, true, true, true>(L + RING_OFF, g, S, E);
        __syncthreads(); if (tid == 0) __hip_atomic_fetch_add(ctl + CW_WGDONE, 1u, __ATOMIC_RELAXED, __HIP_MEMORY_SCOPE_AGENT);
        STAMP(15); STAMP(16);
    }
    if (IN(8)) {
        PH_SETUP
        pg8::Gemm g{HB, WD, 0, D, DEXP, (size_t)D * DEXP * 2, nullptr, 0}; if (tid == 0) { LAS unsigned* sl = (LAS unsigned*)(L + 133120 + 1024); sl[0] = __hip_atomic_fetch_add(ctl + CW_QUEUE, 1u, RLX_AGENT); sl[2] = 0u; }
        pg8::grouped_table((LAS int*)(L + 133120), (const unsigned*)(ctl + CW_CNT), tid); pg8::GroupedOrderDep S{{(const LAS int*)(L + 133120), 4, G, vcu}, (const unsigned*)(ctl + CW_DONE), 16u, (unsigned*)(ctl + CW_QUEUE), (LAS unsigned*)(L + 133120 + 1024), (const unsigned*)(ctl + CW_WGDONE), (unsigned)G};
        pg8::EpiE2 E{YB};
        pg8::gemm_phase<pg8::EpiE2, pg8::GroupedOrderDep, true, true, false>(L + RING_OFF, g, S, E);
        STAMP(17); if (BOTH(8)) GRID_BAR(); STAMP(18);
    }
    if (IN(9)) {
        PH_SETUP
        LAS int* sbase = (LAS int*)(L + 133120);
        pg8::grouped_table(sbase, (const unsigned*)(ctl + CW_CNT), tid);
        const float* C4 = CV + 3 * BATCH * D;
        for (int mb = gw; mb < M; mb += 64 * NGW) {
            const int ml = mb + lane * NGW; int s0l = 0, s1l = 0; float w0l = 0.f, w1l = 0.f;
            if (ml < M) { const int e0 = TOKE[2 * ml], e1 = TOKE[2 * ml + 1]; s0l = sbase[e0] * 256 + TOKP[2 * ml]; s1l = sbase[e1] * 256 + TOKP[2 * ml + 1]; w0l = TOKW[2 * ml]; w1l = TOKW[2 * ml + 1]; }
        for (int k0 = 0; k0 < 64 && mb + k0 * NGW < M; k0 += 4) {
            v4u ya[4][2], yc[4][2], xb[4][2]; float w0[4], w1[4]; int mrow[4];
#pragma unroll
            for (int q = 0; q < 4; ++q) { const int k = k0 + q; const bool live = mb + k * NGW < M; const int ks = live ? k : 0; const int m = mb + ks * NGW;
                mrow[q] = m;
                const size_t s0 = (size_t)__builtin_amdgcn_readlane(s0l, ks), s1 = (size_t)__builtin_amdgcn_readlane(s1l, ks);
                w0[q] = __uint_as_float(__builtin_amdgcn_readlane(__float_as_uint(w0l), ks)); w1[q] = __uint_as_float(__builtin_amdgcn_readlane(__float_as_uint(w1l), ks));
                const bf16* x1r = (const bf16*)(ws + WS_S) + (size_t)m * D;
#pragma unroll
                for (int j = 0; j < 2; ++j) { const int cc = 8 * lane + 512 * j; ya[q][j] = __builtin_nontemporal_load((const GAS v4u*)(YB + s0 * D + cc)); yc[q][j] = __builtin_nontemporal_load((const GAS v4u*)(YB + s1 * D + cc)); xb[q][j] = __builtin_nontemporal_load((const GAS v4u*)(x1r + cc)); } }
#pragma unroll
            for (int q = 0; q < 4; ++q) { const int m = mrow[q]; const int b = m / SEQ;
                float y[16]; float ss = 0.f;
#pragma unroll
                for (int j = 0; j < 2; ++j) { const unsigned aw[4] = {ya[q][j].x, ya[q][j].y, ya[q][j].z, ya[q][j].w}, cw[4] = {yc[q][j].x, yc[q][j].y, yc[q][j].z, yc[q][j].w};
#pragma unroll
                    for (int t = 0; t < 4; ++t) { const float lo = w0[q] * __uint_as_float(aw[t] << 16) + w1[q] * __uint_as_float(cw[t] << 16), hi = w0[q] * __uint_as_float(aw[t] & 0xffff0000u) + w1[q] * __uint_as_float(cw[t] & 0xffff0000u);
                        y[8 * j + 2 * t] = lo; y[8 * j + 2 * t + 1] = hi; ss += lo * lo + hi * hi; } }
                const float rstd = 1.f / sqrtf(wave_sum(ss) * (1.f / D) + EPS);
                float* orow = out + (size_t)m * D;
#pragma unroll
                for (int j = 0; j < 2; ++j) { const int cc = 8 * lane + 512 * j; const f32x4 c4a = *(const f32x4*)(C4 + b * D + cc), c4b = *(const f32x4*)(C4 + b * D + cc + 4); const v4u xv = xb[q][j];
                    const f32x4 xa = {__uint_as_float(xv.x << 16), __uint_as_float(xv.x & 0xffff0000u), __uint_as_float(xv.y << 16), __uint_as_float(xv.y & 0xffff0000u)};
                    const f32x4 xc = {__uint_as_float(xv.z << 16), __uint_as_float(xv.z & 0xffff0000u), __uint_as_float(xv.w << 16), __uint_as_float(xv.w & 0xffff0000u)};
                    const f32x4 ya4 = {y[8 * j], y[8 * j + 1], y[8 * j + 2], y[8 * j + 3]}, yb4 = {y[8 * j + 4], y[8 * j + 5], y[8 * j + 6], y[8 * j + 7]};
                    *(GAS f32x4*)(orow + cc) = xa + c4a * (ya4 * rstd); *(GAS f32x4*)(orow + cc + 4) = xc + c4b * (yb4 * rstd); } }
        }
        }
    }
#ifdef PROBE_T
    STAMP(19);
    if (bx == 0 && tid0 == 0) { volatile LAS unsigned long long* st = (volatile LAS unsigned long long*)(L + LDSCTL_OFF); const unsigned long long d = (unsigned long long)(PROBE_T_EXPR) * 8ull, t0 = __builtin_amdgcn_s_memrealtime();
        while (__builtin_amdgcn_s_memrealtime() - t0 < d) __builtin_amdgcn_s_sleep(8); }
#endif
#if defined(PROBE_SUB) && PROBE_SUB == 1
    if (IN(10)) { PH_SETUP const float* dw = A_->in[7]; const float* dwb = A_->in[8]; const float* lng = A_->in[9]; const float* lnb = A_->in[10];
        hg::conv_stage_w(L, dw, tid); { v4u rg[12]; if (bx < M / 64) hg::conv_tile_ld(rg, bx, U, tid); for (int cu = bx; cu < M / 64; cu += G) { __syncthreads(); hg::conv_tile_st(rg, L, tid); if (cu + G < M / 64) hg::conv_tile_ld(rg, cu + G, U, tid); __syncthreads(); hg::conv_unit(L, cu, dwb, lng, lnb, YCAT, tid, lane, wave); } } }
#elif defined(PROBE_SUB) && PROBE_SUB == 2
    if (IN(10)) { PH_SETUP float* LSEG = (float*)(ws + WS_LSEG); float* ASEG = (float*)(ws + WS_ASEG);
        for (int un = bx; un < BATCH * NHEAD * 8; un += G) hg::x_unit(L, un, KI, V, DEC, LSEG, ASEG, tid, lane, wave); }
#elif defined(PROBE_SUB) && PROBE_SUB == 3
    if (IN(10)) { for (int i = 0; i < 10; ++i) GRID_BAR(); }
#endif
#undef IN
#undef BOTH
}


extern "C" void kernel_launch(void* const* d_in, const int* in_sizes, int n_in, void* d_out, int out_size, void* d_ws, size_t ws_size, hipStream_t stream) {
    if (n_in != 23 || out_size != M * D || ws_size < WS_END) { fprintf(stderr, "kernel_launch: unexpected shapes n_in %d out %d ws %zu\n", n_in, out_size, ws_size); return; }
    static int grid = 0;
    if (grid == 0) {
        int dev = 0, cus = 0;
        if (hipGetDevice(&dev) != hipSuccess || hipDeviceGetAttribute(&cus, hipDeviceAttributeMultiprocessorCount, dev) != hipSuccess) { grid = -1; return; }
        if (hipFuncSetAttribute((const void*)fused_fwd, hipFuncAttributeMaxDynamicSharedMemorySize, LDS_BYTES) != hipSuccess) { fprintf(stderr, "hipFuncSetAttribute failed\n"); grid = -1; return; }
        grid = cus;
    }
    if (grid < 0) return;
    (void)hipMemsetAsync((char*)d_ws + WS_CTL, 0, 1 * MiB, stream);
    Args a{}; for (int i = 0; i < 23; ++i) a.in[i] = (const float*)d_in[i]; a.out = (float*)d_out; a.ws = (unsigned char*)d_ws;
#ifndef PROBE_PHASE
    a.ph_lo = 0; a.ph_hi = 10; a.bar_region = 0;
    hipLaunchKernelGGL(fused_fwd, dim3(grid), dim3(NWAVES * 64), LDS_BYTES, stream, a);
#else
#ifndef PROBE_SUB
#define PROBE_SUB 0
#endif
    a.ph_lo = 0; a.ph_hi = PROBE_PHASE + 1; a.bar_region = 0; hipLaunchKernelGGL(fused_fwd, dim3(grid), dim3(NWAVES * 64), LDS_BYTES, stream, a);
    if (PROBE_SUB >= 1 && PROBE_SUB <= 3) { a.ph_lo = 10; a.ph_hi = 11; } else { a.ph_lo = PROBE_PHASE; a.ph_hi = PROBE_PHASE + 1; }
    a.bar_region = 1; hipLaunchKernelGGL(fused_fwd, dim3(grid), dim3(NWAVES * 64), LDS_BYTES, stream, a);
    if (PROBE_PHASE < 9) { a.ph_lo = PROBE_PHASE + 1; a.ph_hi = 10; a.bar_region = 2; hipLaunchKernelGGL(fused_fwd, dim3(grid), dim3(NWAVES * 64), LDS_BYTES, stream, a); }
#endif
}
```

```cpp
#include <hip/hip_runtime.h>
#include <cstdio>
#include <cstdint>

typedef unsigned short bf16;
#define DI __device__ __forceinline__

constexpr int D = 1024, BATCH = 8, SEQ = 4096, M = BATCH * SEQ;
constexpr int DCONV = 512, DREC = 512, NHEAD = 4, DK = 128, DV = 128, CHUNK = 64, NCHUNK = M / CHUNK;
constexpr int DIN = 3072, CW = 31;
constexpr int NGRP = 4, EPG = 8, NEXP = 32, DEXP = 256;
constexpr float EPS = 1e-6f;
constexpr int LISTCAP = 32768;
constexpr int SLOTS = 2 * M + NEXP * 256;

constexpr size_t MiB = 1u << 20;
constexpr size_t WS_CTL = 0;
constexpr size_t WS_MOD = 1 * MiB;
constexpr size_t WS_LB = WS_MOD + 256 * 1024;
constexpr size_t WS_CV = WS_MOD + 512 * 1024;
constexpr size_t WS_WR = WS_MOD + 768 * 1024;
constexpr size_t WS_WIN = 456 * MiB;
constexpr size_t WS_WOUT = 462 * MiB;
constexpr size_t WS_WGU = 464 * MiB;
constexpr size_t WS_WD = 496 * MiB;
constexpr size_t WS_TOKE = 2 * MiB;
constexpr size_t WS_TOKW = WS_TOKE + 256 * 1024;
constexpr size_t WS_TOKP = WS_TOKW + 256 * 1024;
constexpr size_t WS_LIST = 4 * MiB;
constexpr size_t WS_LSEG = 8 * MiB;
constexpr size_t WS_ASEG = 24 * MiB;
constexpr size_t WS_DEC = 25 * MiB;
constexpr size_t WS_XB = 26 * MiB;
constexpr size_t WS_A = 392 * MiB;
constexpr size_t WS_B = 200 * MiB;
constexpr size_t WS_U = WS_B, WS_QD = WS_B + 32 * MiB, WS_KI = WS_B + 64 * MiB, WS_KE = WS_B + 96 * MiB, WS_V = WS_B + 128 * MiB, WS_GS = WS_B + 160 * MiB;
constexpr size_t WS_Y2 = WS_B;
constexpr size_t WS_HB = WS_B;
constexpr size_t WS_YB = WS_B + 36 * MiB;
constexpr size_t WS_C = 72 * MiB;
constexpr size_t WS_S = 136 * MiB;
constexpr size_t WS_END = 512 * MiB;

DI float bf2f(bf16 v) { return __uint_as_float((unsigned)v << 16); }
DI bf16 f2bf(float f) { unsigned u = __float_as_uint(f); return (bf16)((u + 0x7fffu + ((u >> 16) & 1u)) >> 16); }
DI float sigmoidf_(float x) { return 1.f / (1.f + __expf(-x)); }
DI float siluf_(float x) { return x / (1.f + __expf(-x)); }
DI float clamp8(float v) { return __builtin_amdgcn_fmed3f(v, -448.f, 448.f); }
DI unsigned pack4_fp8(float a, float b, float c, float d) { return (unsigned)__builtin_amdgcn_cvt_pk_fp8_f32(clamp8(c), clamp8(d), __builtin_amdgcn_cvt_pk_fp8_f32(clamp8(a), clamp8(b), 0, false), true); }

__host__ __device__ inline int win_src_col(int n) {
    const int pn = n >> 8, half = (n >> 7) & 1, ch = n & 127;
    if (pn < 4) return (half ? 512 : 0) + 128 * pn + ch;
    if (pn < 8) return 1024 + (half ? 512 : 0) + 128 * (pn - 4) + ch;
    return 2048 + (half ? 512 : 0) + 128 * (pn - 8) + ch;
}


namespace pg8 {
#define PG8_LAS __attribute__((address_space(3)))
typedef unsigned short bf16_t;
typedef short bf16x8 __attribute__((ext_vector_type(8)));
typedef float f32x4 __attribute__((ext_vector_type(4)));
typedef unsigned u32x4 __attribute__((ext_vector_type(4)));
constexpr int BM = 256, BK = 64, HALF = 128, HTB = HALF * BK * 2  , STAGE_BYTES = 8 * HTB, NXCD = 8, WGM = 8;

__host__ __device__ __forceinline__ int lds_byte(int r, int c) { const int st = (r >> 4) * 2 + (c >> 5), rr = r & 15, cc = c & 31, ob = rr * 64 + cc * 2; return st * 1024 + (ob ^ (((ob >> 9) & 1) << 5)); }
__host__ __device__ __forceinline__ void stage_rc(int b, int& R, int& C) { const int st = b / 1024, sb = b % 1024, swz = sb ^ (((sb >> 9) & 1) << 5); R = (st >> 1) * 16 + swz / 64; C = (st & 1) * 32 + (swz % 64) / 2; }
__host__ __device__ __forceinline__ int perm32(int rho) { const int n = rho >> 4, i = rho & 15; return 8 * (i >> 2) + 4 * n + (i & 3); }

struct Unit { int pm, pn, e, r0, ne; };
struct Gemm { const bf16_t* A; const bf16_t* Bt; int M, N, K; size_t b_estride; const int* list; int listcap; };

struct StaticOrder {
    int nM, nN, nwg, G, c;
    __host__ __device__ void init(int M, int N, int G_, int c_) { nM = M / BM; nN = N / BM; nwg = nM * nN; G = G_; c = c_; }
    __host__ __device__ bool next(int i, Unit& u) const {
        const long L = (long)i * G + c; if (L >= nwg) return false;
        int wgid = (int)L; { const int q = nwg / NXCD, r = nwg % NXCD, xcd = wgid % NXCD, off = wgid / NXCD; wgid = (xcd < r ? xcd * (q + 1) : r * (q + 1) + (xcd - r) * q) + off; }
        const int nig = WGM * nN, gid = wgid / nig, fm = gid * WGM, gsz = (nM - fm) < WGM ? (nM - fm) : WGM;
        u.pm = fm + ((wgid % nig) % gsz); u.pn = (wgid % nig) / gsz; u.e = 0; u.r0 = 0; u.ne = 0; return true;
    }
    __device__ __forceinline__ void a_ready(const Unit&) const {}
    __device__ __forceinline__ void done(const Unit&) const {}
};


__device__ __forceinline__ unsigned cvt_pk_bf16(float lo, float hi) { unsigned r; asm volatile("v_cvt_pk_bf16_f32 %0, %1, %2" : "=v"(r) : "v"(lo), "v"(hi)); return r; }
typedef float f32x2 __attribute__((ext_vector_type(2)));

typedef int i32x8 __attribute__((ext_vector_type(8)));
typedef int i32x4 __attribute__((ext_vector_type(4)));
__device__ __forceinline__ i32x8 cat8(const bf16x8 lo, const bf16x8 hi) { const i32x4 a = __builtin_bit_cast(i32x4, lo), b = __builtin_bit_cast(i32x4, hi); return __builtin_shufflevector(a, b, 0, 1, 2, 3, 4, 5, 6, 7); }
template <class Epi, class Sched, bool ALIGN_EPI = false, bool SP2 = false, bool GATHER = false, bool F8 = false>
__device__ __forceinline__ void gemm_phase(PG8_LAS unsigned char* lds, const Gemm g, const Sched& S, const Epi& E) {
    const int tid = threadIdx.x, wid = __builtin_amdgcn_readfirstlane(tid >> 6), lane = tid & 63, wr = wid >> 2, wc = wid & 3, fr = lane & 15, fq = lane >> 4;
    const int K = g.K, nt = K / BK;
    unsigned voffA[2], voffB[2]; unsigned voffAg[2][2];
#pragma unroll
    for (int i = 0; i < 2; ++i) { int R, C; stage_rc(tid * 16 + i * 8192, R, C); const int Rb = Epi::PERM ? ((R & ~31) + perm32(R & 31)) : R;
        voffA[i] = (unsigned)(R * K + C) * 2u; voffB[i] = (unsigned)(Rb * K + C) * 2u; }
    const size_t kstep = (size_t)(BK * 2);
    const size_t hstep = (size_t)HALF * K * 2;
    const size_t tstep = 2 * hstep;
    const unsigned ldsw = (unsigned)wid * 1024u;
    const int aoff = lds_byte(wr * 64 + fr, fq * 8), boff = lds_byte(wc * 32 + fr, fq * 8);
#define PG8_SA(b, h) (((b) * 2 + (h)) * HTB)
#define PG8_SB(b, h) ((4 + (b) * 2 + (h)) * HTB)
#define PG8_STAGE(bufoff, gbase, voff) do { _Pragma("unroll") for (int _i = 0; _i < 2; ++_i) \
        __builtin_amdgcn_global_load_lds((const unsigned*)((const char*)(gbase) + (voff)[_i]), (PG8_LAS unsigned*)(lds + (bufoff) + ldsw + _i * 8192), 16, 0, 0); } while (0)
#define PG8_STAGE_A(bufoff, gbase, h) do { if constexpr (GATHER) { PG8_STAGE(bufoff, gbase, voffAg[h]); } else { PG8_STAGE(bufoff, (gbase) + (h) * hstep, voffA); } } while (0)
#define PG8_GLOAD(dst, un) do { _Pragma("unroll") for (int _h = 0; _h < 2; ++_h) _Pragma("unroll") for (int _i = 0; _i < 2; ++_i) { int _R, _C; stage_rc(tid * 16 + _i * 8192, _R, _C); const int _pos = (un).r0 + 128 * _h + _R; \
        int _tok = 0; if (_pos < (un).ne) _tok = g.list[(size_t)(un).e * g.listcap + _pos] >> 1; dst[_h][_i] = (unsigned)(_tok * K + _C) * 2u; } } while (0)
#define PG8_GPREFETCH(un) do { if (wid == 0) __builtin_amdgcn_global_load_lds((const unsigned*)(g.list + (size_t)(un).e * g.listcap + (un).r0 + lane * 4), (PG8_LAS unsigned*)(lds + STAGE_BYTES + 1024), 16, 0, 0); } while (0)
#define PG8_GFROMLDS(dst, un) do { _Pragma("unroll") for (int _h = 0; _h < 2; ++_h) _Pragma("unroll") for (int _i = 0; _i < 2; ++_i) { int _R, _C; stage_rc(tid * 16 + _i * 8192, _R, _C); const int _p = 128 * _h + _R; \
        int _tok = ((const PG8_LAS int*)(lds + STAGE_BYTES + 1024))[_p] >> 1; if ((un).r0 + _p >= (un).ne) _tok = 0; dst[_h][_i] = (unsigned)(_tok * K + _C) * 2u; } } while (0)
#define PG8_GSWITCH do { if constexpr (GATHER) { if (last && has_next) { PG8_GFROMLDS(voffAg, nxt); } } } while (0)
#define PG8_LDA(dst, b, h) do { _Pragma("unroll") for (int m = 0; m < 4; ++m) _Pragma("unroll") for (int k = 0; k < 2; ++k) dst[m][k] = *(const PG8_LAS bf16x8*)(lds + PG8_SA(b, h) + aoff + m * 2048 + k * 1024); } while (0)
#define PG8_LDB(dst, b, h) do { _Pragma("unroll") for (int n = 0; n < 2; ++n) _Pragma("unroll") for (int k = 0; k < 2; ++k) dst[n][k] = *(const PG8_LAS bf16x8*)(lds + PG8_SB(b, h) + boff + n * 2048 + k * 1024); } while (0)
#define PG8_MMA(ai, bj, At, Bt) do { __builtin_amdgcn_s_setprio(1); _Pragma("unroll") for (int m = 0; m < 4; ++m) _Pragma("unroll") for (int n = 0; n < 2; ++n) { \
        if constexpr (F8) asm volatile("v_mfma_f32_16x16x128_f8f6f4 %0, %1, %2, %0" : "+v"(acc[ai][bj][m][n]) : "v"(cat8(Bt[n][0], Bt[n][1])), "v"(cat8(At[m][0], At[m][1]))); \
        else { _Pragma("unroll") for (int k = 0; k < 2; ++k) acc[ai][bj][m][n] = __builtin_amdgcn_mfma_f32_16x16x32_bf16(Bt[n][k], At[m][k], acc[ai][bj][m][n], 0, 0, 0); } } __builtin_amdgcn_s_setprio(0); } while (0)
#define PG8_WAIT_V(n) asm volatile("s_waitcnt vmcnt(" #n ")" ::: "memory")
#define PG8_WAIT_L(n) asm volatile("s_waitcnt lgkmcnt(" #n ")" ::: "memory")
#define PG8_BAR __builtin_amdgcn_s_barrier()
#define PG8_SCHED __builtin_amdgcn_sched_barrier(0)
    Unit cur, nxt; int ui = 0; cur.e = 0;
    if (!S.next(0, cur)) return;
    f32x4 acc[2][2][4][2];
#pragma unroll
    for (int a = 0; a < 2; ++a)
#pragma unroll
        for (int b = 0; b < 2; ++b)
#pragma unroll
            for (int m = 0; m < 4; ++m)
#pragma unroll
                for (int n = 0; n < 2; ++n) acc[a][b][m][n] = (f32x4){0.f, 0.f, 0.f, 0.f};
    bf16x8 At[4][2], B0[2][2], B1[2][2];
    const char* cA = (const char*)g.A + (GATHER ? (size_t)0 : (size_t)cur.pm * tstep); const char* cB = (const char*)g.Bt + (size_t)cur.e * g.b_estride + (size_t)cur.pn * tstep;
    if constexpr (GATHER) { PG8_GLOAD(voffAg, cur); }
    S.a_ready(cur);
    if constexpr (SP2) {
        PG8_STAGE(PG8_SB(0, 0), cB, voffB); PG8_STAGE(PG8_SB(0, 1), cB + hstep, voffB); PG8_STAGE_A(PG8_SA(0, 0), cA, 0); PG8_STAGE_A(PG8_SA(0, 1), cA, 1);
        if (wr == 1) PG8_BAR;
        PG8_WAIT_V(2); PG8_BAR;
        PG8_STAGE(PG8_SB(1, 0), cB + kstep, voffB); PG8_STAGE_A(PG8_SA(1, 0), cA + kstep, 0); PG8_STAGE(PG8_SB(1, 1), cB + hstep + kstep, voffB);
        PG8_WAIT_V(6); PG8_BAR;
    } else {
        PG8_STAGE(PG8_SB(0, 0), cB, voffB); PG8_STAGE_A(PG8_SA(0, 0), cA, 0); PG8_STAGE(PG8_SB(0, 1), cB + hstep, voffB); PG8_STAGE_A(PG8_SA(0, 1), cA, 1);
        if (wr == 1) PG8_BAR;
        PG8_WAIT_V(4); PG8_BAR;
        PG8_STAGE(PG8_SB(1, 0), cB + kstep, voffB); PG8_STAGE_A(PG8_SA(1, 0), cA + kstep, 0); PG8_STAGE(PG8_SB(1, 1), cB + hstep + kstep, voffB);
        PG8_WAIT_V(6); PG8_BAR;
    }
    for (;;) {
        nxt.e = cur.e; const bool has_next = S.next(ui + 1, nxt);
        const char* nA = has_next ? (const char*)g.A + (GATHER ? (size_t)0 : (size_t)nxt.pm * tstep) : cA; const char* nB = has_next ? (const char*)g.Bt + (size_t)nxt.e * g.b_estride + (size_t)nxt.pn * tstep : cB;
        if constexpr (GATHER) { if (has_next) { PG8_GPREFETCH(nxt); } }
        for (int t = 0; t < nt; t += 2) {
            const bool last = (t == nt - 2);
            const char* a1 = cA + (size_t)(t + 1) * kstep;
            const char* a2 = last ? nA : cA + (size_t)(t + 2) * kstep; const char* b2 = last ? nB : cB + (size_t)(t + 2) * kstep;
            const char* a3 = a2 + kstep; const char* b3 = b2 + kstep;
            if constexpr (F8) { asm volatile("" : "+s"(a1), "+s"(a2), "+s"(b2), "+s"(a3), "+s"(b3)); }
            if (last && has_next) S.a_ready(nxt);
            if constexpr (SP2) {
            PG8_LDB(B0, 0, 0); PG8_LDB(B1, 0, 1); PG8_SCHED; PG8_LDA(At, 0, 0); PG8_STAGE_A(PG8_SA(1, 1), a1, 1); PG8_GSWITCH;
            PG8_WAIT_V(8); PG8_WAIT_L(0); PG8_BAR; PG8_MMA(0, 0, At, B0); PG8_MMA(0, 1, At, B1); PG8_BAR; PG8_SCHED;
            PG8_LDA(At, 0, 1); PG8_STAGE(PG8_SB(0, 0), b2, voffB); PG8_STAGE(PG8_SB(0, 1), b2 + hstep, voffB); PG8_STAGE_A(PG8_SA(0, 0), a2, 0);
            PG8_WAIT_V(8); PG8_WAIT_L(0); PG8_BAR; PG8_MMA(1, 0, At, B0); PG8_MMA(1, 1, At, B1); PG8_BAR; PG8_SCHED;
            PG8_LDB(B0, 1, 0); PG8_LDB(B1, 1, 1); PG8_SCHED; PG8_LDA(At, 1, 0); PG8_STAGE_A(PG8_SA(0, 1), a2, 1);
            PG8_WAIT_V(8); PG8_WAIT_L(0); PG8_BAR; PG8_MMA(0, 0, At, B0); PG8_MMA(0, 1, At, B1); PG8_BAR; PG8_SCHED;
            PG8_LDA(At, 1, 1); PG8_STAGE(PG8_SB(1, 0), b3, voffB); PG8_STAGE(PG8_SB(1, 1), b3 + hstep, voffB); PG8_STAGE_A(PG8_SA(1, 0), a3, 0);
            PG8_WAIT_V(8); PG8_WAIT_L(0); PG8_BAR; PG8_MMA(1, 0, At, B0); PG8_MMA(1, 1, At, B1); PG8_BAR; PG8_SCHED;
            } else {
            PG8_LDB(B0, 0, 0); PG8_SCHED; PG8_LDA(At, 0, 0); PG8_STAGE_A(PG8_SA(1, 1), a1, 1); PG8_GSWITCH;
            PG8_WAIT_L(8); PG8_BAR; PG8_WAIT_L(0); PG8_MMA(0, 0, At, B0); PG8_BAR; PG8_SCHED;
            PG8_LDB(B1, 0, 1); PG8_STAGE(PG8_SB(0, 0), b2, voffB);
            PG8_BAR; PG8_WAIT_L(0); PG8_MMA(0, 1, At, B1); PG8_BAR;
            PG8_LDA(At, 0, 1); PG8_STAGE_A(PG8_SA(0, 0), a2, 0);
            PG8_BAR; PG8_WAIT_L(0); PG8_MMA(1, 0, At, B0); PG8_BAR; PG8_SCHED;
            PG8_STAGE(PG8_SB(0, 1), b2 + hstep, voffB);
            PG8_WAIT_V(6); PG8_BAR; PG8_MMA(1, 1, At, B1); PG8_BAR;
            PG8_LDB(B0, 1, 0); PG8_SCHED; PG8_LDA(At, 1, 0); PG8_STAGE_A(PG8_SA(0, 1), a2, 1);
            PG8_WAIT_L(8); PG8_BAR; PG8_WAIT_L(0); PG8_MMA(0, 0, At, B0); PG8_BAR; PG8_SCHED;
            PG8_LDB(B1, 1, 1); PG8_STAGE(PG8_SB(1, 0), b3, voffB);
            PG8_BAR; PG8_WAIT_L(0); PG8_MMA(0, 1, At, B1); PG8_BAR;
            PG8_LDA(At, 1, 1); PG8_STAGE_A(PG8_SA(1, 0), a3, 0);
            PG8_BAR; PG8_WAIT_L(0); PG8_MMA(1, 0, At, B0); PG8_BAR; PG8_SCHED;
            PG8_STAGE(PG8_SB(1, 1), b3 + hstep, voffB);
            PG8_WAIT_V(6); PG8_BAR; PG8_MMA(1, 1, At, B1); PG8_BAR;
            }
        }
        if constexpr (ALIGN_EPI) { if (wr == 0) PG8_BAR; }
        if constexpr (F8) asm volatile("s_nop 15\n\ts_nop 7" ::: "memory");
        if constexpr (!Epi::AFTER_DRAIN) { E(acc, cur, wr, wc, fr, fq); S.done(cur); }
        if (!has_next) break;
#pragma unroll
        for (int a = 0; a < 2; ++a)
#pragma unroll
            for (int b = 0; b < 2; ++b)
#pragma unroll
                for (int m = 0; m < 4; ++m)
#pragma unroll
                    for (int n = 0; n < 2; ++n) acc[a][b][m][n] = (f32x4){0.f, 0.f, 0.f, 0.f};
        cur = nxt; cA = nA; cB = nB; ++ui;
        if constexpr (ALIGN_EPI) { if (wr == 1) PG8_BAR; }
    }
    PG8_WAIT_V(0);
    if constexpr (!ALIGN_EPI) { if (wr == 0) PG8_BAR; }
    PG8_BAR;
    if constexpr (Epi::AFTER_DRAIN) { E.fused(acc, cur, wr, wc, fr, fq, lds, wid, lane); S.done(cur); }
#undef PG8_SA
#undef PG8_SB
#undef PG8_STAGE
#undef PG8_STAGE_A
#undef PG8_GLOAD
#undef PG8_GPREFETCH
#undef PG8_GFROMLDS
#undef PG8_GSWITCH
#undef PG8_LDA
#undef PG8_LDB
#undef PG8_MMA
#undef PG8_WAIT_V
#undef PG8_WAIT_L
#undef PG8_BAR
#undef PG8_SCHED
}
}


namespace pg8 {
__device__ __forceinline__ float rcp_(float x) { return __builtin_amdgcn_rcpf(x); }
__device__ __forceinline__ float sigm_(float x) { return rcp_(1.f + __expf(-x)); }
template <int N> __device__ __forceinline__ float dpp_shr(float x) { return __builtin_bit_cast(float, __builtin_amdgcn_update_dpp(0, __builtin_bit_cast(int, x), 0x110 + N, 0xf, 0xf, false)); }
__device__ __forceinline__ u32x4 pack8(const f32x4 a, const f32x4 b) { u32x4 w; w.x = cvt_pk_bf16(a[0], a[1]); w.y = cvt_pk_bf16(a[2], a[3]); w.z = cvt_pk_bf16(b[0], b[1]); w.w = cvt_pk_bf16(b[2], b[3]); return w; }

constexpr float SC_G1 = 1.f / (8.f * 128.f);
struct EpiG1 {
    static constexpr bool PERM = true, AFTER_DRAIN = false;
    bf16_t *U, *QD, *KI, *KE, *V, *GS; float* DEC; const float* lb;
    __device__ __forceinline__ void operator()(const f32x4 (&acc)[2][2][4][2], const Unit& u, int wr, int wc, int fr, int fq) const {
        const int kind = u.pn >> 2, j = u.pn & 3;
        const int row0 = u.pm * BM + wr * 64 + fr;
        const int oc = 128 * j + wc * 32 + 8 * fq;
        if (kind == 0) {
#pragma unroll
            for (int ai = 0; ai < 2; ++ai)
#pragma unroll
                for (int m = 0; m < 4; ++m) { const size_t o = (size_t)(row0 + ai * HALF + m * 16) * 512 + oc; f32x4 r0, r1;
#pragma unroll
                    for (int e = 0; e < 4; ++e) { r0[e] = (acc[ai][0][m][0][e] * SC_G1) * sigm_(acc[ai][1][m][0][e] * SC_G1); r1[e] = (acc[ai][0][m][1][e] * SC_G1) * sigm_(acc[ai][1][m][1][e] * SC_G1); }
                    *(u32x4*)(U + o) = pack8(r0, r1); asm volatile("" ::: "memory"); }
        } else if (kind == 2) {
#pragma unroll
            for (int ai = 0; ai < 2; ++ai)
#pragma unroll
                for (int m = 0; m < 4; ++m) { const size_t o = (size_t)(row0 + ai * HALF + m * 16) * 512 + oc; f32x4 r0, r1;
#pragma unroll
                    for (int e = 0; e < 4; ++e) { const float g0 = acc[ai][1][m][0][e] * SC_G1, g1 = acc[ai][1][m][1][e] * SC_G1; r0[e] = g0 * sigm_(g0); r1[e] = g1 * sigm_(g1); }
                    *(u32x4*)(V + o) = pack8(acc[ai][0][m][0] * SC_G1, acc[ai][0][m][1] * SC_G1); *(u32x4*)(GS + o) = pack8(r0, r1); asm volatile("" ::: "memory"); }
        } else {
            float oml[8];
            { const f32x4 l0 = *(const f32x4*)(lb + oc), l1 = *(const f32x4*)(lb + oc + 4);
#pragma unroll
              for (int e = 0; e < 4; ++e) { oml[e] = 1.f - l0[e]; oml[4 + e] = 1.f - l1[e]; } }
#pragma unroll
            for (int ai = 0; ai < 2; ++ai) {
                unsigned qpk[4][2], kpk[4][2];
#pragma unroll
                for (int hc = 0; hc < 2; ++hc) {
                    float kk[4][4], bb[4][4];
#pragma unroll
                    for (int m = 0; m < 4; ++m)
#pragma unroll
                        for (int c = 0; c < 4; ++c) { const float f = acc[ai][1][m][hc][c] * SC_G1; const float k = oml[4 * hc + c] * rcp_(1.f + __expf(f)); kk[m][c] = k; bb[m][c] = __logf(1.f - k); }
#pragma unroll
                    for (int m = 0; m < 4; ++m)
#pragma unroll
                        for (int c = 0; c < 4; ++c) { bb[m][c] += dpp_shr<1>(bb[m][c]); bb[m][c] += dpp_shr<2>(bb[m][c]); bb[m][c] += dpp_shr<4>(bb[m][c]); bb[m][c] += dpp_shr<8>(bb[m][c]); }
                    float bl[4];
#pragma unroll
                    for (int c = 0; c < 4; ++c) { const float t0 = __shfl(bb[0][c], 15, 16), t1 = __shfl(bb[1][c], 15, 16), t2 = __shfl(bb[2][c], 15, 16), t3 = __shfl(bb[3][c], 15, 16);
                        bb[1][c] += t0; bb[2][c] += t0 + t1; bb[3][c] += (t0 + t1) + t2; bl[c] = ((t0 + t1) + t2) + t3; }
#pragma unroll
                    for (int m = 0; m < 4; ++m) { float qd[4], ki[4];
#pragma unroll
                        for (int c = 0; c < 4; ++c) { const float q = acc[ai][0][m][hc][c] * SC_G1; const float eb = __expf(bb[m][c]); qd[c] = q * sigm_(q) * eb; ki[c] = kk[m][c] * rcp_(eb); }
                        const unsigned q01 = cvt_pk_bf16(qd[0], qd[1]), q23 = cvt_pk_bf16(qd[2], qd[3]), k01 = cvt_pk_bf16(ki[0], ki[1]), k23 = cvt_pk_bf16(ki[2], ki[3]);
                        if (hc == 0) { qpk[m][0] = q01; qpk[m][1] = q23; kpk[m][0] = k01; kpk[m][1] = k23; }
                        else { const size_t o = (size_t)(row0 + ai * HALF + m * 16) * 512 + oc;
                            *(u32x4*)(QD + o) = (u32x4){qpk[m][0], qpk[m][1], q01, q23}; *(u32x4*)(KI + o) = (u32x4){kpk[m][0], kpk[m][1], k01, k23}; asm volatile("" ::: "memory"); } }
                    if (fr == 0) { float* dp = DEC + (size_t)(4 * u.pm + 2 * ai + wr) * 512 + oc + 4 * hc; f32x4 d0;
#pragma unroll
                        for (int e = 0; e < 4; ++e) d0[e] = __expf(bl[e]);
                        *(f32x4*)dp = d0; }
                }
            }
        }
    }
};

typedef unsigned f32x2u __attribute__((ext_vector_type(2)));
constexpr float SC_E1 = 1.f / (8.f * 128.f), SC_HB = 8.f, SC_E2 = 1.f / (8.f * 64.f);
struct EpiE1 {
    static constexpr bool PERM = true, AFTER_DRAIN = false;
    bf16_t* HB;
    __device__ __forceinline__ void operator()(const f32x4 (&acc)[2][2][4][2], const Unit& u, int wr, int wc, int fr, int fq) const {
        const int row0 = u.pm * BM + wr * 64 + fr, oc = 128 * u.pn + wc * 32 + 8 * fq;
#pragma unroll
        for (int ai = 0; ai < 2; ++ai)
#pragma unroll
            for (int m = 0; m < 4; ++m) { const size_t o = (size_t)(row0 + ai * HALF + m * 16) * 256 + oc; f32x4 r0, r1;
#pragma unroll
                for (int e = 0; e < 4; ++e) { const float g0 = acc[ai][0][m][0][e] * SC_E1, g1 = acc[ai][0][m][1][e] * SC_E1; r0[e] = g0 * sigm_(g0) * (acc[ai][1][m][0][e] * (SC_E1 * SC_HB)); r1[e] = g1 * sigm_(g1) * (acc[ai][1][m][1][e] * (SC_E1 * SC_HB)); }
                { f32x2u w; w.x = pack4_fp8(r0[0], r0[1], r0[2], r0[3]); w.y = pack4_fp8(r1[0], r1[1], r1[2], r1[3]);
                  const unsigned char* p = (const unsigned char*)HB + o; asm volatile("global_store_dwordx2 %0, %1, off sc1\n\ts_nop 1" :: "v"(p), "v"(w) : "memory"); }
            }
    }
};
template <bool F8OUT>
struct EpiE2T {
    static constexpr bool PERM = true, AFTER_DRAIN = false;
    bf16_t* YB; float sc;
    __device__ __forceinline__ void operator()(const f32x4 (&acc)[2][2][4][2], const Unit& u, int wr, int wc, int fr, int fq) const {
        const int row0 = u.pm * BM + wr * 64 + fr, col0 = u.pn * BM + wc * 32 + 8 * fq;
#pragma unroll
        for (int ai = 0; ai < 2; ++ai)
#pragma unroll
            for (int m = 0; m < 4; ++m) {
                if constexpr (F8OUT) { unsigned char* rowp = (unsigned char*)YB + (size_t)(row0 + ai * HALF + m * 16) * 1024 + col0;
#pragma unroll
                    for (int bj = 0; bj < 2; ++bj) { const f32x4 a = acc[ai][bj][m][0] * sc, b = acc[ai][bj][m][1] * sc; f32x2u w;
                        w.x = pack4_fp8(a[0], a[1], a[2], a[3]); w.y = pack4_fp8(b[0], b[1], b[2], b[3]);
                        *(f32x2u*)(rowp + bj * HALF) = w; }
                } else { bf16_t* rowp = YB + (size_t)(row0 + ai * HALF + m * 16) * 1024 + col0;
#pragma unroll
                    for (int bj = 0; bj < 2; ++bj) *(u32x4*)(rowp + bj * HALF) = pack8(acc[ai][bj][m][0] * sc, acc[ai][bj][m][1] * sc); }
                asm volatile("" ::: "memory"); }
    }
};
typedef EpiE2T<false> EpiE2;
struct GroupedOrder {
    const PG8_LAS int* tab; int nN, G, c;
    __device__ bool next(int i, Unit& u) const {
        const long L = (long)i * G + c; const int T = (int)(L / nN), pn = (int)(L % nN);
        if (T >= tab[32]) return false;
        int e = u.e; if (e < 0 || e > 31) e = 0;
        while (e < 31 && T >= tab[e + 1]) ++e;
        u.pm = T; u.pn = pn; u.e = e; u.r0 = (T - tab[e]) * 256; u.ne = tab[64 + e]; return true;
    }
    __device__ __forceinline__ void a_ready(const Unit&) const {}
    __device__ __forceinline__ void done(const Unit&) const {}
};
struct GroupedOrderPub : GroupedOrder {
    unsigned* donecnt;
    __device__ __forceinline__ void done(const Unit& u) const {
        asm volatile("s_waitcnt vmcnt(0)" ::: "memory");
        if ((threadIdx.x & 63) == 0) __hip_atomic_fetch_add(donecnt + 64 * u.pm, 1u, __ATOMIC_RELAXED, __HIP_MEMORY_SCOPE_AGENT);
    }
};
struct GroupedOrderDep : GroupedOrder {
    const unsigned* ready; unsigned need; unsigned* queue; PG8_LAS unsigned* slot; const unsigned* wgdone; unsigned nwg;
    __device__ bool next(int i, Unit& u) const {
        const unsigned L = (unsigned)__builtin_amdgcn_readfirstlane(slot[i & 1]); const unsigned seen = (unsigned)__builtin_amdgcn_readfirstlane(slot[2]);
        unsigned nxt_ticket = 0u; if (threadIdx.x == 0) nxt_ticket = __hip_atomic_fetch_add(queue, 1u, __ATOMIC_RELAXED, __HIP_MEMORY_SCOPE_AGENT);
        const int T = (int)(L / (unsigned)nN), pn = (int)(L % (unsigned)nN);
        const bool ok = T < tab[32];
        if (ok) { int e = u.e; if (e < 0 || e > 31) e = 0;
            while (e < 31 && T >= tab[e + 1]) ++e;
            u.pm = T; u.pn = pn; u.e = e; u.r0 = (T - tab[e]) * 256; u.ne = tab[64 + e];
            if (seen == 0u && threadIdx.x < 64) {
                unsigned alld = 0u;
                if ((unsigned)__builtin_amdgcn_readfirstlane(__hip_atomic_load(wgdone, __ATOMIC_RELAXED, __HIP_MEMORY_SCOPE_AGENT)) >= nwg) alld = 1u;
                else { unsigned polls = 0;
                    while ((unsigned)__builtin_amdgcn_readfirstlane(__hip_atomic_load(ready + 64 * T, __ATOMIC_RELAXED, __HIP_MEMORY_SCOPE_AGENT)) < need) { __builtin_amdgcn_s_sleep(2); if (++polls > (1u << 20)) break; } }
                __builtin_amdgcn_fence(__ATOMIC_ACQUIRE, "agent");
                asm volatile("s_waitcnt vmcnt(0)" ::: "memory");
                if (alld && threadIdx.x == 0) slot[2] = 1u;
            } }
        if (threadIdx.x == 0) slot[(i + 1) & 1] = nxt_ticket;
        asm volatile("s_waitcnt lgkmcnt(0)" ::: "memory"); __builtin_amdgcn_s_barrier(); asm volatile("" ::: "memory");
        return ok;
    }
};
__device__ __forceinline__ void grouped_table(PG8_LAS int* tab, const unsigned* cnt, int tid) {
    if (tid < 32) { const int n = (int)__hip_atomic_load(cnt + tid, __ATOMIC_RELAXED, __HIP_MEMORY_SCOPE_AGENT); tab[64 + tid] = n; int nt = (n + 255) >> 8, incl = nt;
#pragma unroll
        for (int o = 1; o < 32; o <<= 1) { const int t = __shfl_up(incl, o, 32); if (tid >= o) incl += t; }
        tab[tid] = incl - nt; if (tid == 31) tab[32] = incl; }
    __syncthreads();
}
}

constexpr int NWAVES = 8;
constexpr int RING_OFF = 0, RING_BYTES = 131072;
constexpr int LDSCTL_OFF = RING_BYTES, MISC_OFF = LDSCTL_OFF + 320;
constexpr int LDS_BYTES = 147456;
constexpr int CW_CNT = 0;
constexpr int CW_TMO = 64, CW_CODE = 65;
constexpr int CW_BAR = 4096;
constexpr int CW_WGDONE = 3136;
constexpr int CW_QUEUE = 3072;
constexpr int CW_DONE = 40960;
static_assert((CW_DONE + 64 * 288) * 4 <= 256 * 1024, "control words inside the per-call memset");
constexpr int CW_SEAM = 16384, SEAM_BANK = 128 * 64;

#define GAS __attribute__((address_space(1)))
#define LAS __attribute__((address_space(3)))
typedef unsigned v4u __attribute__((ext_vector_type(4)));
typedef unsigned v2u __attribute__((ext_vector_type(2)));
typedef float f32x4 __attribute__((ext_vector_type(4)));
typedef short bf16x8 __attribute__((ext_vector_type(8)));
typedef GAS unsigned gu32;
typedef GAS unsigned long long gu64;
#define RLX_AGENT __ATOMIC_RELAXED, __HIP_MEMORY_SCOPE_AGENT
#define LDS_WAIT() asm volatile("s_waitcnt lgkmcnt(0)" ::: "memory")
#define VM_WAIT() asm volatile("s_waitcnt vmcnt(0)" ::: "memory")
__device__ __forceinline__ unsigned long long rt() { return __builtin_amdgcn_s_memrealtime(); }
__device__ __forceinline__ unsigned pk2(float lo, float hi) { return (unsigned)f2bf(lo) | ((unsigned)f2bf(hi) << 16); }

#define XB_TMO      128
#define XB_XCNT(j)  (256  + 64 * (j))
#define XB_XSUB(j)  (1280 + 64 * (j))
#define XB_XGEN(j)  (2304 + 64 * (j))
#define XB_TOP      3328
#define XB_TOPGEN   3392
#define XCD_BAR_WORDS 3456
#define XB_SPIN_CAP (1u << 18)

__device__ __forceinline__ unsigned xb_ld(unsigned* p)              { return __hip_atomic_load(p, __ATOMIC_RELAXED, __HIP_MEMORY_SCOPE_AGENT); }
__device__ __forceinline__ unsigned xb_add(unsigned* p, unsigned v) { return __hip_atomic_fetch_add(p, v, __ATOMIC_RELAXED, __HIP_MEMORY_SCOPE_AGENT); }
__device__ __forceinline__ unsigned xb_xcc_id() { return (unsigned)__builtin_amdgcn_s_getreg((3 << 11) | 20) & 0xFu; }
#define XB_SPIN(cond, bar) do { unsigned _sp = 0; while (cond) { __builtin_amdgcn_s_sleep(1); \
    if ((++_sp & 255u) == 0u) { if (xb_ld(&(bar)[XB_TMO])) break; if (_sp > XB_SPIN_CAP) { atomicAdd(&(bar)[XB_TMO], 1u); break; } } } } while (0)

struct XcdBarrier {
    unsigned* bar; unsigned x;
    volatile LAS unsigned* st;
};

__device__ __forceinline__ XcdBarrier xcd_barrier_post(unsigned* bar, volatile LAS unsigned* st) {
    XcdBarrier b; b.bar = bar; b.x = xb_xcc_id(); b.st = st;
    if (threadIdx.x == 0) (void)xb_add(&bar[XB_XCNT(b.x)], 1u);
    return b;
}
__device__ __forceinline__ void xcd_barrier_complete(unsigned* bar, unsigned x, unsigned& nloc, unsigned& nx) {
    const unsigned G = gridDim.x * gridDim.y * gridDim.z;
    unsigned sum, cnt, mine, sp = 0u;
    for (;;) {
        sum = 0u; cnt = 0u; mine = 0u;
#pragma unroll
        for (unsigned j = 0; j < 16; ++j) { const unsigned c = xb_ld(&bar[XB_XCNT(j)]); sum += c; cnt += (c > 0u) ? 1u : 0u; mine = (j == x) ? c : mine; }
        if (sum == G) break;
        __builtin_amdgcn_s_sleep(1);
        if ((++sp & 255u) == 0u) { if (xb_ld(&bar[XB_TMO])) break; if (sp > XB_SPIN_CAP) { atomicAdd(&bar[XB_TMO], 1u); break; } }
    }
    nloc = mine > 0u ? mine : 1u; nx = cnt > 0u ? cnt : 1u;
}

__device__ __forceinline__ void xcd_barrier(const XcdBarrier& b) {
    asm volatile("s_waitcnt vmcnt(0)" ::: "memory");
    __syncthreads();
    if (threadIdx.x == 0) {
        unsigned* bar = b.bar;
        __builtin_amdgcn_s_waitcnt(0);
        unsigned nloc = b.st[0], nx = b.st[1];
        if (nloc == 0u) { xcd_barrier_complete(bar, b.x, nloc, nx); b.st[0] = nloc; b.st[1] = nx; }
        const unsigned old = xb_add(&bar[XB_XSUB(b.x)], 1u);
        const unsigned gen = old / nloc;
        if (old + 1u == (gen + 1u) * nloc) {
            __builtin_amdgcn_fence(__ATOMIC_RELEASE, "agent");
            asm volatile("s_waitcnt vmcnt(0)" ::: "memory");
            const unsigned og = xb_add(&bar[XB_TOP], 1u);
            const unsigned tg = og / nx;
            if (og + 1u == (tg + 1u) * nx) xb_add(&bar[XB_TOPGEN], 1u);
            else XB_SPIN(xb_ld(&bar[XB_TOPGEN]) == tg, bar);
            __builtin_amdgcn_fence(__ATOMIC_ACQUIRE, "agent");
            xb_add(&bar[XB_XGEN(b.x)], 1u);
            asm volatile("s_waitcnt vmcnt(0)" ::: "memory");
        } else {
            XB_SPIN(xb_ld(&bar[XB_XGEN(b.x)]) == gen, bar);
            __builtin_amdgcn_fence(__ATOMIC_ACQUIRE, "agent");
            asm volatile("s_waitcnt vmcnt(0)" ::: "memory");
        }
    }
    __syncthreads();
}


namespace hg {
#define HG_DPP(v, ctrl) __builtin_bit_cast(float, __builtin_amdgcn_update_dpp(0, __builtin_bit_cast(int, (v)), (ctrl), 0xf, 0xf, false))
DI float sum8(float v) { v += HG_DPP(v, 0xB1); v += HG_DPP(v, 0x4E); v += HG_DPP(v, 0x141); return v; }
DI float sum64(float v) { v = sum8(v); v += HG_DPP(v, 0x140); const int vi = __builtin_bit_cast(int, v);
    return (__builtin_bit_cast(float, __builtin_amdgcn_readlane(vi, 0)) + __builtin_bit_cast(float, __builtin_amdgcn_readlane(vi, 16))) + (__builtin_bit_cast(float, __builtin_amdgcn_readlane(vi, 32)) + __builtin_bit_cast(float, __builtin_amdgcn_readlane(vi, 48))); }
DI unsigned pk4f8y(float a, float b, float c, float d) { return pack4_fp8(a * 4.f, b * 4.f, c * 4.f, d * 4.f); }
typedef short s16x4 __attribute__((ext_vector_type(4)));
typedef short v4i16_t __attribute__((ext_vector_type(4)));
typedef float f32x16 __attribute__((ext_vector_type(16)));
typedef float f32x2_t __attribute__((ext_vector_type(2)));
typedef __bf16 bf16x2_t __attribute__((ext_vector_type(2)));
typedef LAS const char* lcp;
DI unsigned cvtpk(float lo, float hi) { f32x2_t v = {lo, hi}; bf16x2_t b = __builtin_convertvector(v, bf16x2_t); return __builtin_bit_cast(unsigned, b); }
DI unsigned off_b(unsigned row, unsigned ch) { return 256u * row + 16u * (ch ^ (((row & 3) << 2) | ((row >> 2) & 3))); }
DI int crow(int reg, int h) { return (reg & 3) + 8 * (reg >> 2) + 4 * h; }
DI s16x4 trrd(lcp p) { return __builtin_bit_cast(s16x4, __builtin_amdgcn_ds_read_tr16_b64_v4i16((LAS v4i16_t*)p)); }
DI bf16x8 cat(s16x4 lo, s16x4 hi) { return __builtin_shufflevector(lo, hi, 0, 1, 2, 3, 4, 5, 6, 7); }
DI unsigned tr_addr(int lane, int rb, int c) { const unsigned blk = (lane >> 4) & 1, q = (lane & 15) >> 2, p = lane & 3; return off_b(rb + q, 4 * c + 2 * blk + (p >> 1)) + 8 * (p & 1); }
template <int S> DI bf16x8 pack_step(const f32x16& x) { v4u p; p.x = cvtpk(x[8 * S], x[8 * S + 1]); p.y = cvtpk(x[8 * S + 2], x[8 * S + 3]); p.z = cvtpk(x[8 * S + 4], x[8 * S + 5]); p.w = cvtpk(x[8 * S + 6], x[8 * S + 7]); return __builtin_bit_cast(bf16x8, p); }
#define HG_MFMA(a, b, c) __builtin_amdgcn_mfma_f32_32x32x16_bf16((a), (b), (c), 0, 0, 0)

template <int AUX = 0> DI void tile_dma(const bf16* base, LAS unsigned char* img, int wave, int lane) {
#pragma unroll
    for (int i = 0; i < 2; ++i) { const int p = wave * 2 + i, row = 4 * p + (lane >> 4), ch = (lane & 15) ^ (((row & 3) << 2) | ((row >> 2) & 3));
        __builtin_amdgcn_global_load_lds((const unsigned*)(base + (size_t)row * 512 + ch * 8), (LAS unsigned*)(img + p * 1024), 16, 0, AUX); }
}
constexpr int HG_DL = 133120, HG_NGL = 137216;

DI void x_unit(LAS unsigned char* L, int unit, const bf16* KI, const bf16* V, const float* DEC, float* LSEG, float* ASEG, int tid, int lane, int wave) {
    const int b = unit >> 5, h = (unit >> 3) & 3, seg = unit & 7;
    const int kbh = wave >> 2, nb = wave & 3, hh = lane >> 5;
    const size_t row0 = (size_t)b * SEQ + (size_t)seg * 512; const int c0 = (int)(row0 / CHUNK);
    LAS float* DL = (LAS float*)(L + HG_DL);
    f32x16 S2[2];
#pragma unroll
    for (int i = 0; i < 2; ++i)
#pragma unroll
        for (int r = 0; r < 16; ++r) S2[i][r] = 0.f;
    __syncthreads();
    if (tid < 256) { const int n = tid >> 5, c4 = (tid & 31) * 4; *(LAS f32x4*)(DL + n * 128 + c4) = *(const f32x4*)(DEC + (size_t)(c0 + n) * 512 + h * 128 + c4); }
#define HG_XDMA(n_) do { const size_t rn_ = row0 + (size_t)(n_) * CHUNK; LAS unsigned char* sl_ = L + ((n_) & 3) * 32768; tile_dma(KI + rn_ * 512 + h * 128, sl_, wave, lane); tile_dma(V + rn_ * 512 + h * 128, sl_ + 16384, wave, lane); } while (0)
    HG_XDMA(0); HG_XDMA(1); HG_XDMA(2);
    for (int n = 0; n < 8; ++n) {
        LAS unsigned char* KIi = L + (n & 3) * 32768; LAS unsigned char* Vi = KIi + 16384;
        if (n < 6) asm volatile("s_waitcnt vmcnt(8)" ::: "memory"); else if (n == 6) asm volatile("s_waitcnt vmcnt(4)" ::: "memory"); else asm volatile("s_waitcnt vmcnt(0)" ::: "memory");
        asm volatile("s_waitcnt lgkmcnt(0)" ::: "memory"); __builtin_amdgcn_s_barrier(); asm volatile("" ::: "memory");
        if (n + 3 < 8) HG_XDMA(n + 3);
#pragma unroll
        for (int ks = 0; ks < 4; ++ks) {
            const bf16x8 bv = cat(trrd((lcp)Vi + tr_addr(lane, 16 * ks + 8 * hh, nb)), trrd((lcp)Vi + tr_addr(lane, 16 * ks + 8 * hh + 4, nb)));
#pragma unroll
            for (int i = 0; i < 2; ++i) { const int kb = 2 * kbh + i;
                const bf16x8 a = cat(trrd((lcp)KIi + tr_addr(lane, 16 * ks + 8 * hh, kb)), trrd((lcp)KIi + tr_addr(lane, 16 * ks + 8 * hh + 4, kb)));
                S2[i] = HG_MFMA(a, bv, S2[i]); }
        }
#pragma unroll
        for (int i = 0; i < 2; ++i)
#pragma unroll
            for (int g = 0; g < 4; ++g) { const f32x4 d = *(const LAS f32x4*)(DL + n * 128 + 32 * (2 * kbh + i) + 8 * g + 4 * hh);
#pragma unroll
                for (int e = 0; e < 4; ++e) S2[i][4 * g + e] *= d[e]; }
    }
#pragma unroll
    for (int i = 0; i < 2; ++i) { const int kb = 2 * kbh + i; float* lp = LSEG + ((((size_t)unit * 4 + nb) * 4 + kb) * 16) * 64 + lane;
#pragma unroll
        for (int r = 0; r < 16; ++r) lp[r * 64] = S2[i][r]; }
    if (tid < 128) { float a = 1.f;
#pragma unroll
        for (int n = 0; n < 8; ++n) a *= DL[n * 128 + tid];
        ASEG[unit * 128 + tid] = a; }
#undef HG_XDMA
}

template <class SideLd, class SideFin>
DI void y_unit(LAS unsigned char* L, int unit, const bf16* QD, const bf16* KI, const bf16* V, const bf16* GS, const float* DEC, const float* LSEG,
               bf16* YCAT, int tid, int lane, int wave, const SideLd& side_ld, const SideFin& side_fin) {
    const int b = unit >> 5, h = (unit >> 3) & 3, seg = unit & 7;
    const int cb = wave >> 2, nb = wave & 3, r = lane & 31, hh = lane >> 5;
    const size_t row0 = (size_t)b * SEQ + (size_t)seg * 512; const int c0 = (int)(row0 / CHUNK);
    LAS float* OST = (LAS float*)(L + 98304);
    LAS float* DL = (LAS float*)(L + HG_DL); LAS float* NGL = (LAS float*)(L + HG_NGL);
    __syncthreads();
    if (tid < 256) { const int n = tid >> 5, c4 = (tid & 31) * 4; *(LAS f32x4*)(DL + n * 128 + c4) = *(const f32x4*)(DEC + (size_t)(c0 + n) * 512 + h * 128 + c4); }
    { const size_t o = row0 * 512 + h * 128; tile_dma<2>(QD + o, L, wave, lane); tile_dma<2>(KI + o, L + 16384, wave, lane); tile_dma<2>(V + o, L + 32768, wave, lane); }
    f32x16 S[4];
#pragma unroll
    for (int kb = 0; kb < 4; ++kb)
#pragma unroll
        for (int q = 0; q < 16; ++q) S[kb][q] = 0.f;
    if (seg > 0) { const float* lp = LSEG + (((size_t)(unit - 1) * 4 + nb) * 4) * 16 * 64 + lane;
#pragma unroll
        for (int kb = 0; kb < 4; ++kb)
#pragma unroll
            for (int q = 0; q < 16; ++q) S[kb][q] = lp[(kb * 16 + q) * 64]; }
    const int ec = tid >> 3, edv = (tid & 7) * 16;
    for (int n = 0; n < 8; ++n) {
        LAS unsigned char* QDi = L + (n & 1) * 49152; LAS unsigned char* KIi = QDi + 16384; LAS unsigned char* Vi = QDi + 32768;
        __syncthreads();
        const size_t grow = row0 + (size_t)n * CHUNK + ec;
        const v4u g0 = __builtin_nontemporal_load((const GAS v4u*)(GS + grow * 512 + h * 128 + edv)), g1 = __builtin_nontemporal_load((const GAS v4u*)(GS + grow * 512 + h * 128 + edv + 8));
        if (n + 1 < 8) { const size_t o = (row0 + (size_t)(n + 1) * CHUNK) * 512 + h * 128; LAS unsigned char* nx = L + ((n + 1) & 1) * 49152;
            tile_dma<2>(QD + o, nx, wave, lane); tile_dma<2>(KI + o, nx + 16384, wave, lane); tile_dma<2>(V + o, nx + 32768, wave, lane); }
        side_ld(n, 0);
        f32x16 pt0, pt1;
#pragma unroll
        for (int q = 0; q < 16; ++q) { pt0[q] = 0.f; pt1[q] = 0.f; }
#pragma unroll
        for (int ks = 0; ks < 8; ++ks) {
            const bf16x8 bq = *(const LAS bf16x8*)(QDi + off_b(32 * cb + r, 2 * ks + hh));
            const bf16x8 a0 = *(const LAS bf16x8*)(KIi + off_b(r, 2 * ks + hh));
            pt0 = HG_MFMA(a0, bq, pt0);
            if (cb == 1) { const bf16x8 a1 = *(const LAS bf16x8*)(KIi + off_b(32 + r, 2 * ks + hh)); pt1 = HG_MFMA(a1, bq, pt1); }
        }
        if (cb == 0) {
#pragma unroll
            for (int q = 0; q < 16; ++q) if (crow(q, hh) > r) pt0[q] = 0.f;
        } else {
#pragma unroll
            for (int q = 0; q < 16; ++q) if (crow(q, hh) > r) pt1[q] = 0.f;
        }
        f32x16 O;
#pragma unroll
        for (int q = 0; q < 16; ++q) O[q] = 0.f;
        { const bf16x8 x0 = pack_step<0>(pt0), x1 = pack_step<1>(pt0);
          const bf16x8 v0 = cat(trrd((lcp)Vi + tr_addr(lane, 0 + 4 * hh, nb)), trrd((lcp)Vi + tr_addr(lane, 8 + 4 * hh, nb)));
          const bf16x8 v1 = cat(trrd((lcp)Vi + tr_addr(lane, 16 + 4 * hh, nb)), trrd((lcp)Vi + tr_addr(lane, 24 + 4 * hh, nb)));
          O = HG_MFMA(x0, v0, O); O = HG_MFMA(x1, v1, O); }
        if (cb == 1) { const bf16x8 x0 = pack_step<0>(pt1), x1 = pack_step<1>(pt1);
          const bf16x8 v0 = cat(trrd((lcp)Vi + tr_addr(lane, 32 + 4 * hh, nb)), trrd((lcp)Vi + tr_addr(lane, 40 + 4 * hh, nb)));
          const bf16x8 v1 = cat(trrd((lcp)Vi + tr_addr(lane, 48 + 4 * hh, nb)), trrd((lcp)Vi + tr_addr(lane, 56 + 4 * hh, nb)));
          O = HG_MFMA(x0, v0, O); O = HG_MFMA(x1, v1, O); }
#pragma unroll
        for (int kb = 0; kb < 4; ++kb) {
            const bf16x8 xb0 = pack_step<0>(S[kb]), xb1 = pack_step<1>(S[kb]);
            const unsigned o0 = off_b(32 * cb + r, 4 * kb) + 8 * hh, o1 = off_b(32 * cb + r, 4 * kb + 1) + 8 * hh, o2 = off_b(32 * cb + r, 4 * kb + 2) + 8 * hh, o3 = off_b(32 * cb + r, 4 * kb + 3) + 8 * hh;
            const bf16x8 qa0 = cat(*(const LAS s16x4*)(QDi + o0), *(const LAS s16x4*)(QDi + o1));
            const bf16x8 qa1 = cat(*(const LAS s16x4*)(QDi + o2), *(const LAS s16x4*)(QDi + o3));
            O = HG_MFMA(qa0, xb0, O); O = HG_MFMA(qa1, xb1, O);
        }
        side_fin(n, 0); side_ld(n, 1);
        if (n + 1 < 8) {
#pragma unroll
            for (int ks = 0; ks < 4; ++ks) {
                const bf16x8 bv = cat(trrd((lcp)Vi + tr_addr(lane, 16 * ks + 8 * hh, nb)), trrd((lcp)Vi + tr_addr(lane, 16 * ks + 8 * hh + 4, nb)));
#pragma unroll
                for (int kb = 0; kb < 4; ++kb) {
                    const bf16x8 a = cat(trrd((lcp)KIi + tr_addr(lane, 16 * ks + 8 * hh, kb)), trrd((lcp)KIi + tr_addr(lane, 16 * ks + 8 * hh + 4, kb)));
                    S[kb] = HG_MFMA(a, bv, S[kb]); }
            }
#pragma unroll
            for (int kb = 0; kb < 4; ++kb)
#pragma unroll
                for (int g = 0; g < 4; ++g) { const f32x4 d = *(const LAS f32x4*)(DL + n * 128 + 32 * kb + 8 * g + 4 * hh);
#pragma unroll
                    for (int e = 0; e < 4; ++e) S[kb][4 * g + e] *= d[e]; }
        }
#pragma unroll
        for (int q = 0; q < 16; ++q) OST[(32 * cb + crow(q, hh)) * 128 + 32 * nb + r] = O[q];
        asm volatile("s_waitcnt lgkmcnt(0)" ::: "memory"); __builtin_amdgcn_s_barrier(); asm volatile("" ::: "memory");
        { f32x4 o4[4]; float ss = 0.f;
#pragma unroll
          for (int i = 0; i < 4; ++i) { o4[i] = *(const LAS f32x4*)(OST + ec * 128 + edv + 4 * i); ss += (o4[i].x * o4[i].x + o4[i].y * o4[i].y) + (o4[i].z * o4[i].z + o4[i].w * o4[i].w); }
          ss = sum8(ss);
          const float rstd = 1.f / sqrtf(ss * (1.f / DV) + EPS);
          const unsigned gw_[8] = {g0.x, g0.y, g0.z, g0.w, g1.x, g1.y, g1.z, g1.w};
          unsigned ow[4];
#pragma unroll
          for (int i = 0; i < 4; ++i) { const f32x4 gn = *(const LAS f32x4*)(NGL + edv + 4 * i);
              const float a0 = o4[i].x * rstd * gn.x * __uint_as_float(gw_[2 * i] << 16), a1 = o4[i].y * rstd * gn.y * __uint_as_float(gw_[2 * i] & 0xffff0000u);
              const float a2 = o4[i].z * rstd * gn.z * __uint_as_float(gw_[2 * i + 1] << 16), a3 = o4[i].w * rstd * gn.w * __uint_as_float(gw_[2 * i + 1] & 0xffff0000u);
              ow[i] = pk4f8y(a0, a1, a2, a3); }
          unsigned char* yp = (unsigned char*)YCAT + grow * D + 512 + h * 128 + edv;
          *(GAS v4u*)yp = (v4u){ow[0], ow[1], ow[2], ow[3]}; }
        side_fin(n, 1);
    }
}

DI void conv_stage_w(LAS unsigned char* L, const float* dw, int tid) {
    LAS unsigned* WT = (LAS unsigned*)(L + 96256);
    float wv[CW + 1];
#pragma unroll
    for (int j = 0; j < CW; ++j) wv[j] = dw[j * DCONV + tid];
    wv[CW] = 0.f;
#pragma unroll
    for (int m = 0; m < 16; ++m) WT[m * DCONV + tid] = cvtpk(wv[2 * m], wv[2 * m + 1]);
}
DI void conv_tile_ld(v4u (&rg)[12], int cu, const bf16* U, int tid) {
    const size_t t0 = (size_t)cu * 64; const int trel = (int)(t0 % SEQ);
#pragma unroll
    for (int i = 0; i < 6; ++i) { const int q = tid + 512 * i, a = q >> 6, ch = q & 63; rg[2 * i] = (v4u){0u, 0u, 0u, 0u}; rg[2 * i + 1] = (v4u){0u, 0u, 0u, 0u};
        if (q < 47 * 64) { if (trel - 30 + 2 * a >= 0) rg[2 * i] = __builtin_nontemporal_load((const GAS v4u*)(U + (t0 + 2 * a - 30) * 512 + ch * 8));
                           if (trel - 30 + 2 * a + 1 >= 0) rg[2 * i + 1] = __builtin_nontemporal_load((const GAS v4u*)(U + (t0 + 2 * a + 1 - 30) * 512 + ch * 8)); } }
}
DI void conv_tile_st(const v4u (&rg)[12], LAS unsigned char* L, int tid) {
#pragma unroll
    for (int i = 0; i < 6; ++i) { const int q = tid + 512 * i, a = q >> 6, ch = q & 63; const v4u x0 = rg[2 * i], x1 = rg[2 * i + 1];
        if (q < 47 * 64) {
            *(LAS v4u*)(L + a * 2048 + ch * 32) = (v4u){__builtin_amdgcn_perm(x1.x, x0.x, 0x05040100u), __builtin_amdgcn_perm(x1.x, x0.x, 0x07060302u), __builtin_amdgcn_perm(x1.y, x0.y, 0x05040100u), __builtin_amdgcn_perm(x1.y, x0.y, 0x07060302u)};
            *(LAS v4u*)(L + a * 2048 + ch * 32 + 16) = (v4u){__builtin_amdgcn_perm(x1.z, x0.z, 0x05040100u), __builtin_amdgcn_perm(x1.z, x0.z, 0x07060302u), __builtin_amdgcn_perm(x1.w, x0.w, 0x05040100u), __builtin_amdgcn_perm(x1.w, x0.w, 0x07060302u)}; } }
}
typedef __bf16 bf16v2 __attribute__((ext_vector_type(2)));
DI float dot2bf(unsigned a, unsigned b, float c) { return __builtin_amdgcn_fdot2_f32_bf16(__builtin_bit_cast(bf16v2, a), __builtin_bit_cast(bf16v2, b), c, false); }
DI void conv_unit(LAS unsigned char* L, int cu, const float* dwb, const float* lng, const float* lnb, bf16* YCAT, int tid, int lane, int wave) {
    const size_t t0 = (size_t)cu * 64;
#pragma unroll 1
    for (int pass = 0; pass < 2; ++pass) {
        const int rbase = 8 * wave + 4 * pass;
        float acc[4][8];
        { const f32x4 b0 = *(const f32x4*)(dwb + 8 * lane), b1 = *(const f32x4*)(dwb + 8 * lane + 4);
#pragma unroll
          for (int rr = 0; rr < 4; ++rr) { acc[rr][0] = b0.x; acc[rr][1] = b0.y; acc[rr][2] = b0.z; acc[rr][3] = b0.w; acc[rr][4] = b1.x; acc[rr][5] = b1.y; acc[rr][6] = b1.z; acc[rr][7] = b1.w; } }
        unsigned Ea[8], Oa[8], Eb[8], Ob[8];
#pragma unroll
        for (int c = 0; c < 8; ++c) { Ea[c] = 0u; Oa[c] = 0u; Eb[c] = 0u; Ob[c] = 0u; }
        LAS const unsigned char* up = L + (rbase >> 1) * 2048 + lane * 32; LAS const unsigned char* wp = L + 96256 + lane * 32;
#define CV_STEP(s, Ec, Oc, Ep, Op) do { v4u e0 = {0u, 0u, 0u, 0u}, e1 = {0u, 0u, 0u, 0u}; if ((s) <= 15) { e0 = *(const LAS v4u*)(wp + (s) * 2048); e1 = *(const LAS v4u*)(wp + (s) * 2048 + 16); } \
        Ec[0] = e0.x; Ec[1] = e0.y; Ec[2] = e0.z; Ec[3] = e0.w; Ec[4] = e1.x; Ec[5] = e1.y; Ec[6] = e1.z; Ec[7] = e1.w; \
        const v4u u0 = *(const LAS v4u*)(up + (s) * 2048), u1 = *(const LAS v4u*)(up + (s) * 2048 + 16); const unsigned uu[8] = {u0.x, u0.y, u0.z, u0.w, u1.x, u1.y, u1.z, u1.w}; \
        _Pragma("unroll") for (int c = 0; c < 8; ++c) { Oc[c] = __builtin_amdgcn_perm(Ec[c], Ep[c], 0x05040302u); \
            acc[0][c] = dot2bf(Ec[c], uu[c], acc[0][c]); acc[1][c] = dot2bf(Oc[c], uu[c], acc[1][c]); acc[2][c] = dot2bf(Ep[c], uu[c], acc[2][c]); acc[3][c] = dot2bf(Op[c], uu[c], acc[3][c]); } } while (0)
#pragma unroll 1
        for (int sb = 0; sb < 8; ++sb) { const int s0 = 2 * sb; CV_STEP(s0, Ea, Oa, Eb, Ob); CV_STEP(s0 + 1, Eb, Ob, Ea, Oa); }
        CV_STEP(16, Ea, Oa, Eb, Ob);
#undef CV_STEP
        const f32x4 lg0 = *(const f32x4*)(lng + 8 * lane), lg1 = *(const f32x4*)(lng + 8 * lane + 4), lb0 = *(const f32x4*)(lnb + 8 * lane), lb1 = *(const f32x4*)(lnb + 8 * lane + 4);
        const float lgv[8] = {lg0.x, lg0.y, lg0.z, lg0.w, lg1.x, lg1.y, lg1.z, lg1.w}, lbv[8] = {lb0.x, lb0.y, lb0.z, lb0.w, lb1.x, lb1.y, lb1.z, lb1.w};
#pragma unroll
        for (int rr = 0; rr < 4; ++rr) {
            float s1 = 0.f, s2 = 0.f;
#pragma unroll
            for (int c = 0; c < 8; ++c) { s1 += acc[rr][c]; s2 += acc[rr][c] * acc[rr][c]; }
            s1 = sum64(s1); s2 = sum64(s2);
            const float mu = s1 * (1.f / DCONV), var = fmaxf(s2 * (1.f / DCONV) - mu * mu, 0.f), rstd = 1.f / sqrtf(var + EPS);
            float y[8];
#pragma unroll
            for (int c = 0; c < 8; ++c) { const float z = (acc[rr][c] - mu) * rstd * lgv[c] + lbv[c]; y[c] = z * pg8::sigm_(z); }
            *(GAS v2u*)((unsigned char*)YCAT + (t0 + rbase + rr) * D + 8 * lane) = (v2u){pk4f8y(y[0], y[1], y[2], y[3]), pk4f8y(y[4], y[5], y[6], y[7])};
        }
    }
}
}

struct Args { const float* in[23]; float* out; unsigned char* ws; int ph_lo, ph_hi, bar_region, pad; };

__device__ __forceinline__ float wave_sum(float v) {
    v += __builtin_bit_cast(float, __builtin_amdgcn_update_dpp(0, __builtin_bit_cast(int, v), 0xB1, 0xf, 0xf, false));
    v += __builtin_bit_cast(float, __builtin_amdgcn_update_dpp(0, __builtin_bit_cast(int, v), 0x4E, 0xf, 0xf, false));
    v += __builtin_bit_cast(float, __builtin_amdgcn_update_dpp(0, __builtin_bit_cast(int, v), 0x141, 0xf, 0xf, false));
    v += __builtin_bit_cast(float, __builtin_amdgcn_update_dpp(0, __builtin_bit_cast(int, v), 0x140, 0xf, 0xf, false));
    const int vi = __builtin_bit_cast(int, v);
    return (__builtin_bit_cast(float, __builtin_amdgcn_readlane(vi, 0)) + __builtin_bit_cast(float, __builtin_amdgcn_readlane(vi, 16))) + (__builtin_bit_cast(float, __builtin_amdgcn_readlane(vi, 32)) + __builtin_bit_cast(float, __builtin_amdgcn_readlane(vi, 48)));
}
struct TrItem { const float* src; bf16* dst; int ldsrc, srccol0, k0, lddst, dstrow0; float qs; };
DI unsigned pk4f8(float a, float b, float c, float d) { return pack4_fp8(a, b, c, d); }
__device__ __forceinline__ void tr_ld(float (&tv)[32], const TrItem& t, int lane) {
#pragma unroll
    for (int i = 0; i < 32; ++i) { const int kk = 2 * i + (lane >> 5); tv[i] = __builtin_nontemporal_load(t.src + (size_t)(t.k0 + kk) * t.ldsrc + t.srccol0 + (lane & 31)); }
}
__device__ __forceinline__ void tr_st(const float (&tv)[32], const TrItem& t, LAS float* scr, int lane) {
#pragma unroll
    for (int i = 0; i < 32; ++i) { const int kk = 2 * i + (lane >> 5); scr[kk * 33 + (lane & 31)] = tv[i]; }
    LDS_WAIT(); asm volatile("" ::: "memory");
    if (t.qs != 0.f) {
        const int c4 = lane & 3; const float qs = t.qs;
#pragma unroll
        for (int j = 0; j < 2; ++j) { const int n = (lane >> 2) + 16 * j; const LAS float* s = scr + (16 * c4) * 33 + n; v4u o;
            o.x = pk4f8(s[0 * 33] * qs, s[1 * 33] * qs, s[2 * 33] * qs, s[3 * 33] * qs); o.y = pk4f8(s[4 * 33] * qs, s[5 * 33] * qs, s[6 * 33] * qs, s[7 * 33] * qs);
            o.z = pk4f8(s[8 * 33] * qs, s[9 * 33] * qs, s[10 * 33] * qs, s[11 * 33] * qs); o.w = pk4f8(s[12 * 33] * qs, s[13 * 33] * qs, s[14 * 33] * qs, s[15 * 33] * qs);
            *(GAS v4u*)((unsigned char*)t.dst + (size_t)(t.dstrow0 + n) * t.lddst + t.k0 + 16 * c4) = o; }
        LDS_WAIT(); asm volatile("" ::: "memory");
        return;
    }
    const int c = lane & 7;
#pragma unroll
    for (int j = 0; j < 4; ++j) { const int n = (lane >> 3) + 8 * j; const LAS float* s = scr + (8 * c) * 33 + n;
        v4u o; o.x = hg::cvtpk(s[0 * 33], s[1 * 33]); o.y = hg::cvtpk(s[2 * 33], s[3 * 33]); o.z = hg::cvtpk(s[4 * 33], s[5 * 33]); o.w = hg::cvtpk(s[6 * 33], s[7 * 33]);
        *(GAS v4u*)(t.dst + (size_t)(t.dstrow0 + n) * t.lddst + t.k0 + 8 * c) = o; }
    LDS_WAIT(); asm volatile("" ::: "memory");
}

__device__ __forceinline__ void tr_direct_ld(float (&tv)[16], const TrItem& t, int hf, int lane) {
#pragma unroll
    for (int i = 0; i < 16; ++i) tv[i] = __builtin_nontemporal_load(t.src + (size_t)(t.k0 + 32 * (lane >> 5) + 16 * hf + i) * t.ldsrc + t.srccol0 + (lane & 31));
}
__device__ __forceinline__ void tr_direct_st(const float (&tv)[16], const TrItem& t, int hf, int lane) {
    const float qs = t.qs; unsigned w[4];
#pragma unroll
    for (int i = 0; i < 4; ++i) w[i] = pack4_fp8(tv[4 * i] * qs, tv[4 * i + 1] * qs, tv[4 * i + 2] * qs, tv[4 * i + 3] * qs);
    unsigned char* p = (unsigned char*)t.dst + (size_t)(t.dstrow0 + (lane & 31)) * t.lddst + t.k0 + 32 * (lane >> 5) + 16 * hf;
    *(GAS v4u*)p = (v4u){w[0], w[1], w[2], w[3]};
}
__global__ void __launch_bounds__(NWAVES * 64, 2) fused_fwd(Args args) {
    extern __shared__ __attribute__((aligned(16))) unsigned char lds[];
    LAS unsigned char* L = (LAS unsigned char*)lds;
    volatile LAS unsigned* MISC = (volatile LAS unsigned*)(L + MISC_OFF);
    const int tid0 = threadIdx.x, wave = __builtin_amdgcn_readfirstlane(tid0 >> 6);
    const int G = gridDim.x, bx = blockIdx.x;
    const int vcu = (G % 8 == 0) ? (bx % 8) * (G / 8) + bx / 8 : bx;
    typedef const __attribute__((address_space(4))) Args* kargp;
#define KARGS() ({ kargp p_ = (kargp)__builtin_amdgcn_kernarg_segment_ptr(); asm volatile("" : "+s"(p_)); p_; })
#define PH_SETUP int tid = threadIdx.x; asm volatile("" : "+v"(tid)); const int lane = tid & 63; (void)lane; kargp A_ = KARGS(); unsigned char* ws = A_->ws; gu32* ctl = (gu32*)(ws + WS_CTL); const float* x = A_->in[0]; float* out = A_->out; \
    float* MOD = (float*)(ws + WS_MOD); float* LB = (float*)(ws + WS_LB); float* CV = (float*)(ws + WS_CV); \
    bf16 *WIN = (bf16*)(ws + WS_WIN), *WOUT = (bf16*)(ws + WS_WOUT), *WGU = (bf16*)(ws + WS_WGU), *WD = (bf16*)(ws + WS_WD), *WR = (bf16*)(ws + WS_WR); \
    bf16 *HA = (bf16*)(ws + WS_A), *U = (bf16*)(ws + WS_U), *QD = (bf16*)(ws + WS_QD), *KI = (bf16*)(ws + WS_KI), *KE = (bf16*)(ws + WS_KE), *V = (bf16*)(ws + WS_V), *GS = (bf16*)(ws + WS_GS); \
    bf16 *HB = (bf16*)(ws + WS_HB), *YB = (bf16*)(ws + WS_YB), *YCAT = (bf16*)(ws + WS_C); float* DEC = (float*)(ws + WS_DEC); \
    int* TOKE = (int*)(ws + WS_TOKE); float* TOKW = (float*)(ws + WS_TOKW); int* TOKP = (int*)(ws + WS_TOKP); int* LIST = (int*)(ws + WS_LIST); \
    (void)x; (void)out; (void)MOD; (void)LB; (void)CV; (void)WIN; (void)WOUT; (void)WGU; (void)WD; (void)WR; (void)HA; (void)U; (void)QD; (void)KI; (void)KE; (void)V; (void)GS; (void)HB; (void)YB; (void)YCAT; (void)DEC; (void)TOKE; (void)TOKW; (void)TOKP; (void)LIST; (void)ctl;
    for (int u = tid0; u < (LDS_BYTES - LDSCTL_OFF) / 4; u += NWAVES * 64) ((LAS unsigned*)(L + LDSCTL_OFF))[u] = 0u;
    __syncthreads();
    XcdBarrier bar = xcd_barrier_post((unsigned*)((gu32*)(args.ws + WS_CTL) + CW_BAR) + args.bar_region * XCD_BAR_WORDS, MISC + 8);
    const int lo = args.ph_lo, hi = args.ph_hi;
#ifdef PROBE_T
#define STAMP(i) do { if (threadIdx.x == 0) { const unsigned long long t_ = __builtin_amdgcn_s_memrealtime(); ((volatile LAS unsigned long long*)(L + LDSCTL_OFF))[i] = t_; if ((i) & 1) ((unsigned long long*)(args.ws + WS_XB))[((i) >> 1) * 256 + blockIdx.x] = t_; } } while (0)
#else
#define STAMP(i) do { } while (0)
#endif
    STAMP(0);
#ifndef PH_ENABLE
#define PH_ENABLE 0x3FF
#endif
#define IN(k) ((((k) >= 10) || ((PH_ENABLE >> (k)) & 1)) && lo <= (k) && (k) < hi)
#define BOTH(k) (IN(k) && IN((k) + 1))
#define GRID_BAR() xcd_barrier(bar)
    const int gw = vcu * NWAVES + wave, NGW = G * NWAVES;

    if (IN(0)) {
        PH_SETUP
        const float* c = A_->in[1]; const float* w_ada = A_->in[2]; float* MODP = (float*)(ws + WS_XB);
        const float* w_in = A_->in[6]; const float* w_out = A_->in[13]; const float* w_gate = A_->in[20]; const float* w_up = A_->in[21]; const float* w_down = A_->in[22];
        if (bx < 192) {
            LAS float* sc = (LAS float*)(L);
            LAS float* red = (LAS float*)(L + 32768);
            for (int i = tid; i < BATCH * D; i += 512) { const float v = c[i]; sc[i] = v / (1.f + __expf(-v)); }
            __syncthreads();
            const int cg = bx >> 2, kq = bx & 3, c4 = tid & 31, kg = tid >> 5, n0 = cg * 128 + 4 * c4, kbase = kq * 256 + kg * 16;
            f32x4 wv[16];
#pragma unroll
            for (int kk = 0; kk < 16; ++kk) wv[kk] = __builtin_nontemporal_load((const GAS f32x4*)(w_ada + (size_t)(kbase + kk) * (6 * D) + n0));
            f32x4 a8[BATCH];
#pragma unroll
            for (int b = 0; b < BATCH; ++b) a8[b] = (f32x4){0.f, 0.f, 0.f, 0.f};
#pragma unroll
            for (int kk = 0; kk < 16; ++kk) {
#pragma unroll
                for (int b = 0; b < BATCH; ++b) a8[b] += wv[kk] * sc[b * D + kbase + kk]; }
#pragma unroll
            for (int b = 0; b < BATCH; ++b) *(LAS f32x4*)(red + (kg * BATCH + b) * 128 + 4 * c4) = a8[b];
            __syncthreads();
#pragma unroll
            for (int r = 0; r < 2; ++r) { const int o = tid + 512 * r, b = o >> 7, cc = o & 127; float s = 0.f;
#pragma unroll
                for (int k2 = 0; k2 < 16; ++k2) s += red[(k2 * BATCH + b) * 128 + cc];
                MODP[(size_t)(kq * BATCH + b) * (6 * D) + cg * 128 + cc] = s; }
            __syncthreads();
        } else if (bx == 192) {
            const float* lbl = A_->in[11];
            { const float a = lbl[tid], b = lbl[DREC + tid], m = fmaxf(a, b); const float ea = __expf(a - m), eb = __expf(b - m); LB[tid] = ea / (ea + eb); }
        }
        { const float* wrg = A_->in[16]; const float* wre = A_->in[18];
          for (int i = bx * 512 + tid; i < 48 * D; i += G * 512) { const int n = i / D, k = i % D; float v = 0.f; if (n < 4) v = wrg[k * 4 + n]; else if (n < 36) v = wre[k * 32 + (n - 4)]; WR[i] = (bf16)f2bf(v); } }
        LAS float* scr = (LAS float*)(L + RING_OFF + wave * 16384);
        constexpr int I_IN = 16 * 96, I_OUT = 16 * 32, I_GU = NEXP * 16 * 16, I_D = NEXP * 4 * 32;
        constexpr int NIT = I_IN + I_OUT; (void)I_GU; (void)I_D;
        auto decode = [&](int it) -> TrItem { int r = it; TrItem t;
            if (r < I_IN) { const int kb = r / 96, nb = r % 96; t = TrItem{w_in, WIN, DIN, win_src_col(32 * nb), 64 * kb, D, 32 * nb, 128.f}; return t; } r -= I_IN;
            if (r < I_OUT) { const int kb = r / 32, nb = r % 32; t = TrItem{w_out, WOUT, D, 32 * nb, 64 * kb, D, 32 * nb, 128.f}; return t; } r -= I_OUT;
            { const int kb = (r / 32) % 16, nb = r % 32; t = TrItem{w_out, WOUT, D, 32 * nb, 64 * kb, D, 32 * nb, 128.f}; return t; } };
        (void)w_gate; (void)w_up; (void)w_down;
        const bool split = (G == 256); const int NA = split ? 0 : NIT;     const int xw = (bx - 192) * NWAVES + wave;
        auto item = [&](int j) -> int { if (j < NA / NGW || !split) { const int it = j * NGW + gw; return it < NA || !split ? (it < NIT ? it : -1) : -1; }
                                         if (bx < 192) return -1; const int it = NA + (j - NA / NGW) * 512 + xw; return it < NIT ? it : -1; };
        { int j = 0; TrItem ta, tb; float va[32], vb[32];
          int it = item(0); if (it >= 0) { ta = decode(it); tr_ld(va, ta, lane); }
          while (it >= 0) {
              const int it2 = item(j + 1); if (it2 >= 0) { tb = decode(it2); tr_ld(vb, tb, lane); }
              tr_st(va, ta, scr, lane);
              if (it2 < 0) break;
              const int it3 = item(j + 2); if (it3 >= 0) { ta = decode(it3); tr_ld(va, ta, lane); }
              tr_st(vb, tb, scr, lane);
              it = it3; j += 2; } }
        STAMP(1); if (BOTH(0)) GRID_BAR(); STAMP(2);
    }
    if (IN(1)) {
        PH_SETUP
        const float* g1 = A_->in[4]; const float* gpost = A_->in[5]; const float* gpre = A_->in[14]; const float* gpostf = A_->in[15];
        const float* MODP = (const float*)(ws + WS_XB); const float* b_ada = A_->in[3];
        auto modv = [&](int b, int col) -> float { const float* p = MODP + (size_t)b * (6 * D) + col; return ((p[0] + p[(size_t)BATCH * 6 * D]) + (p[(size_t)2 * BATCH * 6 * D] + p[(size_t)3 * BATCH * 6 * D])) + b_ada[col]; };
        for (int i = bx * 512 + tid; i < BATCH * D; i += G * 512) { const int b = i / D, cc = i % D;
            CV[i] = modv(b, 2 * D + cc) * gpost[cc]; CV[BATCH * D + i] = gpre[cc] * (1.f + modv(b, 4 * D + cc)); CV[2 * BATCH * D + i] = modv(b, 3 * D + cc); CV[3 * BATCH * D + i] = modv(b, 5 * D + cc) * gpostf[cc]; }
        const int WPB = NGW / BATCH, pb = gw / WPB, pw = gw % WPB, KMAX = (SEQ - pw + WPB - 1) / WPB;
        auto p1_ld = [&](f32x4 (&v)[4][4], int k0) {
#pragma unroll
            for (int q = 0; q < 4; ++q) { int k = k0 + q; if (k >= KMAX) k = k0;
                const GAS f32x4* xr = (const GAS f32x4*)(x + ((size_t)pb * SEQ + pw + (size_t)WPB * k) * D) + lane;
#pragma unroll
                for (int j = 0; j < 4; ++j) v[q][j] = __builtin_nontemporal_load(xr + 64 * j); } };
        f32x4 pgs[4], psh[4];
        { auto modv4 = [&](int col) -> f32x4 { const float* p = MODP + (size_t)pb * (6 * D) + col; return ((*(const f32x4*)p + *(const f32x4*)(p + (size_t)BATCH * 6 * D)) + (*(const f32x4*)(p + (size_t)2 * BATCH * 6 * D) + *(const f32x4*)(p + (size_t)3 * BATCH * 6 * D))) + *(const f32x4*)(b_ada + col); };
#pragma unroll
          for (int j = 0; j < 4; ++j) { const int cc = 4 * lane + 256 * j; const f32x4 gg = *(const f32x4*)(g1 + cc), sc = modv4(D + cc); pgs[j] = gg * (sc + 1.f); psh[j] = modv4(cc); } }
        auto p1_do = [&](const f32x4 (&v)[4][4], int k0) {
#pragma unroll
            for (int q = 0; q < 4; ++q) { int k = k0 + q; if (k >= KMAX) k = k0; const size_t m = (size_t)pb * SEQ + pw + (size_t)WPB * k; float s = 0.f;
#pragma unroll
                for (int j = 0; j < 4; ++j) s += (v[q][j].x * v[q][j].x + v[q][j].y * v[q][j].y) + (v[q][j].z * v[q][j].z + v[q][j].w * v[q][j].w);
                const float rstd = 1.f / sqrtf(wave_sum(s) * (1.f / D) + EPS);
                GAS unsigned* o4 = (GAS unsigned*)((unsigned char*)HA + m * D) + lane;
#pragma unroll
                for (int j = 0; j < 4; ++j) { const f32x4 o = (v[q][j] * rstd) * pgs[j] + psh[j];
                    o4[64 * j] = pk4f8(o.x * 8.f, o.y * 8.f, o.z * 8.f, o.w * 8.f); } } };
        { f32x4 va[4][4], vb[4][4]; int k0 = 0;
          if (k0 < KMAX) p1_ld(va, k0);
          while (k0 < KMAX) {
              const int k1 = k0 + 4; if (k1 < KMAX) p1_ld(vb, k1);
              p1_do(va, k0);
              k0 = k1; if (k0 >= KMAX) break;
              const int k2 = k0 + 4; if (k2 < KMAX) p1_ld(va, k2);
              p1_do(vb, k0);
              k0 = k2; } }
        STAMP(3); if (BOTH(1)) GRID_BAR(); STAMP(4);
    }
    if (IN(2)) {
        PH_SETUP
        pg8::Gemm g{HA, WIN, M, DIN, D / 2, 0, nullptr, 0}; pg8::StaticOrder S; S.init(M, DIN, G, bx);
        pg8::EpiG1 E{U, QD, KI, KE, V, GS, DEC, LB};
        pg8::gemm_phase<pg8::EpiG1, pg8::StaticOrder, true, true, false, true>(L + RING_OFF, g, S, E);
        STAMP(5); if (BOTH(2)) GRID_BAR(); STAMP(6);
    }
    if (IN(3)) {
        PH_SETUP
        const float* dw = A_->in[7]; const float* dwb = A_->in[8]; const float* lng = A_->in[9]; const float* lnb = A_->in[10];
        float* LSEG = (float*)(ws + WS_LSEG); float* ASEG = (float*)(ws + WS_ASEG);
        hg::conv_stage_w(L, dw, tid);
        { v4u rg[12]; if (bx < M / 64) hg::conv_tile_ld(rg, bx, U, tid);
          for (int cu = bx; cu < M / 64; cu += G) {
              __syncthreads();
              hg::conv_tile_st(rg, L, tid);
              if (cu + G < M / 64) hg::conv_tile_ld(rg, cu + G, U, tid);
              __syncthreads();
              hg::conv_unit(L, cu, dwb, lng, lnb, YCAT, tid, lane, wave); } }
        for (int un = bx; un < BATCH * NHEAD * 8; un += G) hg::x_unit(L, un, KI, V, DEC, LSEG, ASEG, tid, lane, wave);
        STAMP(7); if (BOTH(3)) GRID_BAR(); STAMP(8);
    }
    if (IN(4)) {
        PH_SETUP
        const float* LSEG = (const float*)(ws + WS_LSEG); const float* ASEG = (const float*)(ws + WS_ASEG); const float* ng = A_->in[12];
        if (tid < 32) *(LAS f32x4*)(L + hg::HG_NGL + tid * 16) = *(const f32x4*)(ng + tid * 4);
        for (int j = wave * G + bx; j < BATCH * NHEAD * 16; j += NWAVES * G) { const int bh = j >> 4, nbkb = j & 15, kb = j & 3, hh = lane >> 5;
#pragma unroll
            for (int hf = 0; hf < 2; ++hf) {
                float Lr[7][8]; f32x4 Ar[7][2];
#pragma unroll
                for (int sg = 0; sg < 7; ++sg) { const int un = bh * 8 + sg; const float* lp = LSEG + ((size_t)(un * 16 + nbkb) * 16) * 64 + lane; const float* ap = ASEG + un * 128 + 32 * kb + 4 * hh;
#pragma unroll
                    for (int g2 = 0; g2 < 2; ++g2) { const int g = 2 * hf + g2; Ar[sg][g2] = *(const f32x4*)(ap + 8 * g);
#pragma unroll
                        for (int e = 0; e < 4; ++e) Lr[sg][4 * g2 + e] = lp[(4 * g + e) * 64]; } }
                float s8[8];
#pragma unroll
                for (int i = 0; i < 8; ++i) s8[i] = 0.f;
#pragma unroll
                for (int sg = 0; sg < 7; ++sg) { const int un = bh * 8 + sg; float* lp = (float*)LSEG + ((size_t)(un * 16 + nbkb) * 16) * 64 + lane;
#pragma unroll
                    for (int g2 = 0; g2 < 2; ++g2) { const int g = 2 * hf + g2;
#pragma unroll
                        for (int e = 0; e < 4; ++e) { s8[4 * g2 + e] = Ar[sg][g2][e] * s8[4 * g2 + e] + Lr[sg][4 * g2 + e]; lp[(4 * g + e) * 64] = s8[4 * g2 + e]; } } } } }
        GRID_BAR();
        const float* w_gate = A_->in[20]; const float* w_up = A_->in[21]; const float* w_down = A_->in[22];
        constexpr int I_GU = NEXP * 16 * 16, I_SIDE = I_GU + NEXP * 4 * 32;
        auto sdecode = [&](int r) -> TrItem { TrItem t;
            if (r < I_GU) { const int e = r / 256, kb = (r % 256) / 16, nb = r % 16; const int n = 32 * nb, pn = n >> 8, half = (n >> 7) & 1, ch = 128 * pn + (n & 127);
                t = TrItem{(half ? w_up : w_gate) + (size_t)e * D * DEXP, (bf16*)((unsigned char*)WGU + (size_t)e * 512 * D), DEXP, ch, 64 * kb, D, n, 128.f}; return t; } r -= I_GU;
            { const int e = r / 128, kb = (r % 128) / 32, nb = r % 32; t = TrItem{w_down + (size_t)e * DEXP * D, (bf16*)((unsigned char*)WD + (size_t)e * D * DEXP), D, 32 * nb, 64 * kb, DEXP, 32 * nb, 64.f}; return t; } };
        float sv[16]; int sdone = 0;
        auto side_ld = [&](int n, int hf) { const int r = (sdone + n) * NGW + gw; if (n < 6 && r < I_SIDE) { const TrItem t_ = sdecode(r); tr_direct_ld(sv, t_, hf, lane); } };
        auto side_fin = [&](int n, int hf) { const int r = (sdone + n) * NGW + gw; if (n < 6 && r < I_SIDE) { const TrItem t_ = sdecode(r); tr_direct_st(sv, t_, hf, lane); } };
        for (int un = bx; un < BATCH * NHEAD * 8; un += G) { hg::y_unit(L, un, QD, KI, V, GS, DEC, LSEG, YCAT, tid, lane, wave, side_ld, side_fin); sdone += 6; }
        for (int j = sdone; j * NGW + gw < I_SIDE; ++j) { const TrItem t_ = sdecode(j * NGW + gw); tr_direct_ld(sv, t_, 0, lane); tr_direct_st(sv, t_, 0, lane); tr_direct_ld(sv, t_, 1, lane); tr_direct_st(sv, t_, 1, lane); }
        STAMP(9); if (BOTH(4)) GRID_BAR(); STAMP(10);
    }
    if (IN(5)) {
        PH_SETUP
        pg8::Gemm g{YCAT, WOUT, M, D, D / 2, 0, nullptr, 0}; pg8::StaticOrder S; S.init(M, D, G, bx);
        pg8::EpiE2 E{(bf16*)(ws + WS_Y2), 1.f / (4.f * 128.f)};
        pg8::gemm_phase<pg8::EpiE2, pg8::StaticOrder, true, true, false, true>(L + RING_OFF, g, S, E);
        STAMP(11); if (BOTH(5)) GRID_BAR(); STAMP(12);
    }

    if (IN(6)) {
        PH_SETUP
        const float* brg = A_->in[17]; const float* bre = A_->in[19];
        gu32* cntw = ctl + CW_CNT;
#if defined(PROBE_SUB) && PROBE_SUB == 4
        if (lo == 6 && hi == 7) { TOKE = (int*)(ws + WS_LSEG); TOKW = (float*)(ws + WS_LSEG + 1 * MiB); TOKP = (int*)(ws + WS_LSEG + 2 * MiB); LIST = (int*)(ws + WS_LSEG + 4 * MiB); cntw = ctl + 2048; }
#endif
        typedef float f32x4r __attribute__((ext_vector_type(4)));
        { v4u wr_[9];
#pragma unroll
          for (int i = 0; i < 9; ++i) { const int q = tid + 512 * i, n = q >> 7, kc = q & 127; wr_[i] = *(const GAS v4u*)(WR + (size_t)n * D + kc * 8); }
#pragma unroll
          for (int i = 0; i < 9; ++i) { const int q = tid + 512 * i, n = q >> 7, kc = q & 127; *(LAS v4u*)(L + n * 2048 + ((kc ^ (n & 15)) << 4)) = wr_[i]; } }
        LAS float* LG = (LAS float*)(L + 98304);
        LAS unsigned* lcnt = (LAS unsigned*)(L + 98304 + 128 * 49 * 4);
        __syncthreads();
        const bf16* Y2 = (const bf16*)(ws + WS_Y2); bf16* X1B = (bf16*)(ws + WS_S);
        for (int blk = bx; blk < M / 128; blk += G) {
            if (tid < 64) lcnt[tid] = 0u;
            { const int bb_ = (blk * 128) / SEQ; const float* cs_ = CV + BATCH * D + bb_ * D + (tid < 256 ? 0 : 2 * BATCH * D - BATCH * D - 256 * 4) + tid * 4; *(LAS f32x4*)(L + 73728 + tid * 16) = *(const f32x4*)cs_; }
            __syncthreads();
            const int R0 = blk * 128 + 16 * wave; float myrs = 0.f;
            { const int bb = (blk * 128) / SEQ; const float* c1p = CV + bb * D; const float* c2p = CV + BATCH * D + bb * D; const float* c3p = CV + 2 * BATCH * D + bb * D;
              f32x4 c1[4], c2[4], c3[4];
#pragma unroll
              for (int j = 0; j < 4; ++j) { const int cc = 4 * lane + 256 * j; c1[j] = *(const f32x4*)(c1p + cc); c2[j] = *(const f32x4*)(c2p + cc); c3[j] = *(const f32x4*)(c3p + cc); }
#define P6_LD(yv, xv, r_) do { _Pragma("unroll") for (int q = 0; q < 2; ++q) { const size_t m = (size_t)(R0 + (r_) + q); \
                  _Pragma("unroll") for (int j = 0; j < 4; ++j) { const int cc = 4 * lane + 256 * j; yv[q][j] = __builtin_nontemporal_load((const GAS v2u*)(Y2 + m * D + cc)); xv[q][j] = __builtin_nontemporal_load((const GAS f32x4*)(x + m * D + cc)); } } } while (0)
#define P6_DO(yv, xv, r_) do { _Pragma("unroll") for (int q = 0; q < 2; ++q) { const size_t m = (size_t)(R0 + (r_) + q); \
                      f32x4 yf[4]; float s1 = 0.f; \
                      _Pragma("unroll") for (int j = 0; j < 4; ++j) { const v2u a = yv[q][j]; yf[j] = (f32x4){__uint_as_float(a.x << 16), __uint_as_float(a.x & 0xffff0000u), __uint_as_float(a.y << 16), __uint_as_float(a.y & 0xffff0000u)}; \
                          s1 += (yf[j].x * yf[j].x + yf[j].y * yf[j].y) + (yf[j].z * yf[j].z + yf[j].w * yf[j].w); } \
                      const float rs1 = 1.f / sqrtf(wave_sum(s1) * (1.f / D) + EPS); \
                      f32x4 x1[4]; float s2 = 0.f; \
                      _Pragma("unroll") for (int j = 0; j < 4; ++j) { x1[j] = xv[q][j] + c1[j] * (yf[j] * rs1); s2 += (x1[j].x * x1[j].x + x1[j].y * x1[j].y) + (x1[j].z * x1[j].z + x1[j].w * x1[j].w); } \
                      const float rs2 = 1.f / sqrtf(wave_sum(s2) * (1.f / D) + EPS); if ((lane & 15) == (r_) + q) myrs = rs2; \
                      _Pragma("unroll") for (int j = 0; j < 4; ++j) { const int cc = 4 * lane + 256 * j; const f32x4 h = (x1[j] * rs2) * c2[j] + c3[j]; \
                          *(GAS v2u*)(X1B + m * D + cc) = (v2u){hg::cvtpk(x1[j].x, x1[j].y), hg::cvtpk(x1[j].z, x1[j].w)}; \
                          *(GAS unsigned*)((unsigned char*)YCAT + m * D + cc) = pk4f8(h.x * 8.f, h.y * 8.f, h.z * 8.f, h.w * 8.f); } } } while (0)
              { v2u yA[2][4], yB[2][4]; f32x4 xA[2][4], xB[2][4];
                P6_LD(yA, xA, 0);
#pragma unroll 1
                for (int r0 = 0; r0 < 16; r0 += 4) {
                    P6_LD(yB, xB, r0 + 2);
                    P6_DO(yA, xA, r0);
                    if (r0 + 4 < 16) P6_LD(yA, xA, r0 + 4);
                    P6_DO(yB, xB, r0 + 2); } }
#undef P6_LD
#undef P6_DO
              asm volatile("s_waitcnt vmcnt(0)" ::: "memory");
            }

            f32x4r acc0 = {0.f, 0.f, 0.f, 0.f}, acc1 = acc0, acc2 = acc0;
            const bf16* arow = X1B + (size_t)(R0 + (lane & 15)) * D + 8 * (lane >> 4);
            const int nl = lane & 15, ql = lane >> 4;
#pragma unroll 1
            for (int kh = 0; kh < 32; kh += 16) {
            bf16x8 afr[16];
#pragma unroll
            for (int kq = 0; kq < 16; ++kq) afr[kq] = *(const GAS bf16x8*)(arow + (kh + kq) * 32);
#pragma unroll
            for (int kq = 0; kq < 16; ++kq) { const int kb = kh + kq;
                bf16x8 a;
                { const v4u xa = __builtin_bit_cast(v4u, afr[kq]); const int k0 = kb * 32 + 8 * ql;
                  const f32x4 ca0 = *(const LAS f32x4*)(L + 73728 + k0 * 4), ca1 = *(const LAS f32x4*)(L + 73728 + k0 * 4 + 16), cb0 = *(const LAS f32x4*)(L + 77824 + k0 * 4), cb1 = *(const LAS f32x4*)(L + 77824 + k0 * 4 + 16);
                  v4u ha;
                  ha.x = hg::cvtpk((__uint_as_float(xa.x << 16) * myrs) * ca0.x + cb0.x, (__uint_as_float(xa.x & 0xffff0000u) * myrs) * ca0.y + cb0.y);
                  ha.y = hg::cvtpk((__uint_as_float(xa.y << 16) * myrs) * ca0.z + cb0.z, (__uint_as_float(xa.y & 0xffff0000u) * myrs) * ca0.w + cb0.w);
                  ha.z = hg::cvtpk((__uint_as_float(xa.z << 16) * myrs) * ca1.x + cb1.x, (__uint_as_float(xa.z & 0xffff0000u) * myrs) * ca1.y + cb1.y);
                  ha.w = hg::cvtpk((__uint_as_float(xa.w << 16) * myrs) * ca1.z + cb1.z, (__uint_as_float(xa.w & 0xffff0000u) * myrs) * ca1.w + cb1.w);
                  a = __builtin_bit_cast(bf16x8, ha); }
                const int kc = kb * 4 + ql;
                const bf16x8 b0 = *(const LAS bf16x8*)(L + (nl) * 2048 + ((kc ^ nl) << 4));
                const bf16x8 b1 = *(const LAS bf16x8*)(L + (16 + nl) * 2048 + ((kc ^ nl) << 4));
                bf16x8 b2 = *(const LAS bf16x8*)(L + (32 + (nl & 3)) * 2048 + ((kc ^ (nl & 3)) << 4)); if (nl >= 4) b2 = (bf16x8){0, 0, 0, 0, 0, 0, 0, 0};
                acc0 = __builtin_amdgcn_mfma_f32_16x16x32_bf16(a, b0, acc0, 0, 0, 0);
                acc1 = __builtin_amdgcn_mfma_f32_16x16x32_bf16(a, b1, acc1, 0, 0, 0);
                acc2 = __builtin_amdgcn_mfma_f32_16x16x32_bf16(a, b2, acc2, 0, 0, 0);
            } }
#pragma unroll
            for (int r = 0; r < 4; ++r) { const int row = 16 * wave + ql * 4 + r; LG[row * 49 + nl] = acc0[r]; LG[row * 49 + 16 + nl] = acc1[r]; LG[row * 49 + 32 + nl] = acc2[r]; }
            __syncthreads();
            int e0 = 0, e1 = 0; unsigned lp0 = 0, lp1 = 0; float w0 = 0.f, w1 = 0.f;
            if (tid < 128) {
                const LAS float* lg = LG + tid * 49;
                float gv = -1e30f; int gi = 0; float gl[4];
#pragma unroll
                for (int i = 0; i < 4; ++i) { gl[i] = lg[i] + brg[i]; if (gl[i] > gv) { gv = gl[i]; gi = i; } }
                float se = 0.f;
#pragma unroll
                for (int i = 0; i < 4; ++i) se += __expf(gl[i] - gv);
                const float gp = 1.f / se;
                float v0 = -1e30f, v1 = -1e30f; int i0 = 0, i1 = 0;
#pragma unroll
                for (int i = 0; i < 8; ++i) { const float el = lg[4 + gi * 8 + i] + bre[gi * 8 + i]; if (el > v0) { v1 = v0; i1 = i0; v0 = el; i0 = i; } else if (el > v1) { v1 = el; i1 = i; } }
                const float p1 = __expf(v1 - v0), ps = 1.f + p1;
                e0 = gi * 8 + i0; e1 = gi * 8 + i1; w0 = gp / ps; w1 = gp * p1 / ps;
                lp0 = atomicAdd((unsigned*)&lcnt[e0], 1u); lp1 = atomicAdd((unsigned*)&lcnt[e1], 1u);
            }
            __syncthreads();
            if (tid < 32) lcnt[32 + tid] = __hip_atomic_fetch_add((unsigned*)(cntw + tid), lcnt[tid], __ATOMIC_RELAXED, __HIP_MEMORY_SCOPE_AGENT);
            __syncthreads();
            if (tid < 128) { const int tok = blk * 128 + tid; const int q0 = (int)(lcnt[32 + e0] + lp0), q1 = (int)(lcnt[32 + e1] + lp1);
                TOKE[tok * 2] = e0; TOKE[tok * 2 + 1] = e1; TOKW[tok * 2] = w0; TOKW[tok * 2 + 1] = w1; TOKP[tok * 2] = q0; TOKP[tok * 2 + 1] = q1;
                LIST[e0 * LISTCAP + q0] = tok * 2; LIST[e1 * LISTCAP + q1] = tok * 2 + 1; }
            __syncthreads();
        }
        STAMP(13); if (BOTH(6)) GRID_BAR(); STAMP(14);
    }
    if (IN(7)) {
        PH_SETUP
        pg8::Gemm g{YCAT, WGU, 0, 512, D / 2, (size_t)512 * D, LIST, LISTCAP};     pg8::grouped_table((LAS int*)(L + 133120), (const unsigned*)(ctl + CW_CNT), tid); pg8::GroupedOrderPub S{{(const LAS int*)(L + 133120), 2, G, vcu}, (unsigned*)(ctl + CW_DONE)};
        pg8::EpiE1 E{HB};
        pg8::gemm_phase<pg8::EpiE1, pg8::GroupedOrderPub, true, true, true, true>(L + RING_OFF, g, S, E);
        __syncthreads(); if (tid == 0) __hip_atomic_fetch_add(ctl + CW_WGDONE, 1u, __ATOMIC_RELAXED, __HIP_MEMORY_SCOPE_AGENT);
        STAMP(15); STAMP(16);
    }
    if (IN(8)) {
        PH_SETUP
        pg8::Gemm g{HB, WD, 0, D, DEXP / 2, (size_t)D * DEXP, nullptr, 0}; if (tid == 0) { LAS unsigned* sl = (LAS unsigned*)(L + 133120 + 1024); sl[0] = __hip_atomic_fetch_add(ctl + CW_QUEUE, 1u, RLX_AGENT); sl[2] = 0u; }
        pg8::grouped_table((LAS int*)(L + 133120), (const unsigned*)(ctl + CW_CNT), tid); pg8::GroupedOrderDep S{{(const LAS int*)(L + 133120), 4, G, vcu}, (const unsigned*)(ctl + CW_DONE), 16u, (unsigned*)(ctl + CW_QUEUE), (LAS unsigned*)(L + 133120 + 1024), (const unsigned*)(ctl + CW_WGDONE), (unsigned)G};
        pg8::EpiE2T<true> E{YB, pg8::SC_E2 * 16.f};
        pg8::gemm_phase<pg8::EpiE2T<true>, pg8::GroupedOrderDep, true, true, false, true>(L + RING_OFF, g, S, E);
        STAMP(17); if (BOTH(8)) GRID_BAR(); STAMP(18);
    }
    if (IN(9)) {
        PH_SETUP
        LAS int* sbase = (LAS int*)(L + 133120);
        pg8::grouped_table(sbase, (const unsigned*)(ctl + CW_CNT), tid);
        const float* C4 = CV + 3 * BATCH * D;
        const int WPB = NGW / BATCH, pb = gw / WPB, pw = gw % WPB, KMAX = (SEQ - pw + WPB - 1) / WPB;
        f32x4 c4r[4];
#pragma unroll
        for (int i = 0; i < 4; ++i) c4r[i] = *(const f32x4*)(C4 + pb * D + 4 * lane + 256 * i);
#define P9_ROW(k_) (pb * SEQ + pw + WPB * (k_))
        for (int mb = 0; mb < KMAX; mb += 64) {
            const int ml = (mb + lane < KMAX) ? P9_ROW(mb + lane) : M; int s0l = 0, s1l = 0; float w0l = 0.f, w1l = 0.f;
            if (ml < M) { const int e0 = TOKE[2 * ml], e1 = TOKE[2 * ml + 1]; s0l = sbase[e0] * 256 + TOKP[2 * ml]; s1l = sbase[e1] * 256 + TOKP[2 * ml + 1]; w0l = TOKW[2 * ml]; w1l = TOKW[2 * ml + 1]; }
#define P9_LD(ya, yc, xb, w0, w1, mrow, k0_) do { _Pragma("unroll") for (int q = 0; q < 4; ++q) { const int k = (k0_) + q; const bool live = mb + k < KMAX; const int ks = live ? k : 0; const int m = P9_ROW(mb + ks);   \
                mrow[q] = m; \
                const size_t s0 = (size_t)__builtin_amdgcn_readlane(s0l, ks), s1 = (size_t)__builtin_amdgcn_readlane(s1l, ks); \
                w0[q] = __uint_as_float(__builtin_amdgcn_readlane(__float_as_uint(w0l), ks)); w1[q] = __uint_as_float(__builtin_amdgcn_readlane(__float_as_uint(w1l), ks)); \
                const bf16* x1r = (const bf16*)(ws + WS_S) + (size_t)m * D + 4 * lane; const unsigned char* ya_p = (const unsigned char*)YB + s0 * D + 4 * lane; const unsigned char* yc_p = (const unsigned char*)YB + s1 * D + 4 * lane; \
                ya[q] = (v4u){__builtin_nontemporal_load((const GAS unsigned*)(ya_p)), __builtin_nontemporal_load((const GAS unsigned*)(ya_p + 256)), __builtin_nontemporal_load((const GAS unsigned*)(ya_p + 512)), __builtin_nontemporal_load((const GAS unsigned*)(ya_p + 768))}; \
                yc[q] = (v4u){__builtin_nontemporal_load((const GAS unsigned*)(yc_p)), __builtin_nontemporal_load((const GAS unsigned*)(yc_p + 256)), __builtin_nontemporal_load((const GAS unsigned*)(yc_p + 512)), __builtin_nontemporal_load((const GAS unsigned*)(yc_p + 768))}; \
                { const v2u t0 = __builtin_nontemporal_load((const GAS v2u*)(x1r)), t1 = __builtin_nontemporal_load((const GAS v2u*)(x1r + 256)), t2 = __builtin_nontemporal_load((const GAS v2u*)(x1r + 512)), t3 = __builtin_nontemporal_load((const GAS v2u*)(x1r + 768)); \
                  xb[q][0] = (v4u){t0.x, t0.y, t1.x, t1.y}; xb[q][1] = (v4u){t2.x, t2.y, t3.x, t3.y}; } } } while (0)
#define P9_DO(ya, yc, xb, w0, w1, mrow) do { _Pragma("unroll") for (int q = 0; q < 4; ++q) { const int m = mrow[q]; \
                float y[16]; float ss = 0.f; \
                { const unsigned aw[4] = {ya[q].x, ya[q].y, ya[q].z, ya[q].w}, cw[4] = {yc[q].x, yc[q].y, yc[q].z, yc[q].w}; \
                  _Pragma("unroll") for (int t = 0; t < 4; ++t) { const pg8::f32x2 a0 = __builtin_amdgcn_cvt_pk_f32_fp8((int)aw[t], false), a1 = __builtin_amdgcn_cvt_pk_f32_fp8((int)aw[t], true), c0 = __builtin_amdgcn_cvt_pk_f32_fp8((int)cw[t], false), c1 = __builtin_amdgcn_cvt_pk_f32_fp8((int)cw[t], true); \
                      y[4 * t] = w0[q] * a0.x + w1[q] * c0.x; y[4 * t + 1] = w0[q] * a0.y + w1[q] * c0.y; y[4 * t + 2] = w0[q] * a1.x + w1[q] * c1.x; y[4 * t + 3] = w0[q] * a1.y + w1[q] * c1.y; \
                      ss += (y[4 * t] * y[4 * t] + y[4 * t + 1] * y[4 * t + 1]) + (y[4 * t + 2] * y[4 * t + 2] + y[4 * t + 3] * y[4 * t + 3]); } } \
                const float rstd = 1.f / sqrtf(wave_sum(ss) * (1.f / D) + EPS * 256.f);       \
                float* orow = out + (size_t)m * D + 4 * lane; \
                _Pragma("unroll") for (int j = 0; j < 2; ++j) { const f32x4 c4a = c4r[2 * j], c4b = c4r[2 * j + 1]; const v4u xv = xb[q][j]; \
                    const f32x4 xa = {__uint_as_float(xv.x << 16), __uint_as_float(xv.x & 0xffff0000u), __uint_as_float(xv.y << 16), __uint_as_float(xv.y & 0xffff0000u)}; \
                    const f32x4 xc = {__uint_as_float(xv.z << 16), __uint_as_float(xv.z & 0xffff0000u), __uint_as_float(xv.w << 16), __uint_as_float(xv.w & 0xffff0000u)}; \
                    const f32x4 ya4 = {y[8 * j], y[8 * j + 1], y[8 * j + 2], y[8 * j + 3]}, yb4 = {y[8 * j + 4], y[8 * j + 5], y[8 * j + 6], y[8 * j + 7]}; \
                    *(GAS f32x4*)(orow + 512 * j) = xa + c4a * (ya4 * rstd); *(GAS f32x4*)(orow + 512 * j + 256) = xc + c4b * (yb4 * rstd); } } } while (0)
        { v4u yaA[4], ycA[4], xbA[4][2], yaB[4], ycB[4], xbB[4][2]; float w0A[4], w1A[4], w0B[4], w1B[4]; int mA[4], mB[4];
          const int nk = KMAX - mb < 64 ? KMAX - mb : 64;
          P9_LD(yaA, ycA, xbA, w0A, w1A, mA, 0);
#pragma unroll 1
          for (int k0 = 0; k0 < nk; k0 += 8) {
              if (k0 + 4 < nk) P9_LD(yaB, ycB, xbB, w0B, w1B, mB, k0 + 4);
              P9_DO(yaA, ycA, xbA, w0A, w1A, mA);
              if (k0 + 4 >= nk) break;
              if (k0 + 8 < nk) P9_LD(yaA, ycA, xbA, w0A, w1A, mA, k0 + 8);
              P9_DO(yaB, ycB, xbB, w0B, w1B, mB); } }
#undef P9_LD
#undef P9_DO
#undef P9_ROW
        }
    }
#ifdef PROBE_T
    STAMP(19);
#ifdef PROBE_ATOM
    { unsigned acc_ = 0; if ((threadIdx.x & 63) == 0) { for (int i_ = 0; i_ < PROBE_ATOM; ++i_) acc_ += __hip_atomic_fetch_add((unsigned*)(args.ws + WS_CTL) + 16384 + (acc_ & 0u), 1u, __ATOMIC_RELAXED, __HIP_MEMORY_SCOPE_AGENT); if (acc_ == 0xffffffffu) args.out[0] = 1.f; } }
#endif
#ifdef PROBE_ARR_K
    GRID_BAR();
#endif
    if (bx == 0 && tid0 == 0) { volatile LAS unsigned long long* st = (volatile LAS unsigned long long*)(L + LDSCTL_OFF);
        unsigned long long amax = 0, amin = ~0ull, a0 = 0, asum = 0; (void)amax; (void)amin; (void)a0; (void)asum;
#ifdef PROBE_ARR_K
        { const unsigned long long* arr = (const unsigned long long*)(args.ws + WS_XB) + PROBE_ARR_K * 256; a0 = arr[0];
          for (int b = 0; b < 256; ++b) { const unsigned long long v = arr[b]; amax = v > amax ? v : amax; amin = v < amin ? v : amin; asum += v - a0 + 100000ull; } }
        unsigned long long axmax = 0, axmin = ~0ull, axarg = 0; (void)axmax; (void)axmin; (void)axarg;
#ifdef PROBE_AX
        { const unsigned long long* arr = (const unsigned long long*)(args.ws + WS_XB) + PROBE_ARR_K * 256;
#pragma unroll 1
          for (int j = 0; j < 8; ++j) { unsigned long long s_ = 0;
#pragma unroll 1
              for (int b = j; b < 256; b += 8) s_ += arr[b] - amin;
              s_ >>= 5; if (s_ > axmax) { axmax = s_; axarg = j; } axmin = s_ < axmin ? s_ : axmin; } }
#endif
#endif
        const unsigned long long d = (unsigned long long)(PROBE_T_EXPR) * 8ull, t0 = __builtin_amdgcn_s_memrealtime();
        while (__builtin_amdgcn_s_memrealtime() - t0 < d) __builtin_amdgcn_s_sleep(8); }
#endif
#if defined(PROBE_SUB) && PROBE_SUB == 1
    if (IN(10)) { PH_SETUP const float* dw = A_->in[7]; const float* dwb = A_->in[8]; const float* lng = A_->in[9]; const float* lnb = A_->in[10];
        hg::conv_stage_w(L, dw, tid); { v4u rg[12]; if (bx < M / 64) hg::conv_tile_ld(rg, bx, U, tid); for (int cu = bx; cu < M / 64; cu += G) { __syncthreads(); hg::conv_tile_st(rg, L, tid); if (cu + G < M / 64) hg::conv_tile_ld(rg, cu + G, U, tid); __syncthreads(); hg::conv_unit(L, cu, dwb, lng, lnb, YCAT, tid, lane, wave); } } }
#elif defined(PROBE_SUB) && PROBE_SUB == 2
    if (IN(10)) { PH_SETUP float* LSEG = (float*)(ws + WS_LSEG); float* ASEG = (float*)(ws + WS_ASEG);
        for (int un = bx; un < BATCH * NHEAD * 8; un += G) hg::x_unit(L, un, KI, V, DEC, LSEG, ASEG, tid, lane, wave); }
#elif defined(PROBE_SUB) && PROBE_SUB == 3
    if (IN(10)) { for (int i = 0; i < 10; ++i) GRID_BAR(); }
#endif
#undef IN
#undef BOTH
}


extern "C" void kernel_launch(void* const* d_in, const int* in_sizes, int n_in, void* d_out, int out_size, void* d_ws, size_t ws_size, hipStream_t stream) {
    if (n_in != 23 || out_size != M * D || ws_size < WS_END) { fprintf(stderr, "kernel_launch: unexpected shapes n_in %d out %d ws %zu\n", n_in, out_size, ws_size); return; }
    static int grid = 0;
    if (grid == 0) {
        int dev = 0, cus = 0;
        if (hipGetDevice(&dev) != hipSuccess || hipDeviceGetAttribute(&cus, hipDeviceAttributeMultiprocessorCount, dev) != hipSuccess) { grid = -1; return; }
        if (hipFuncSetAttribute((const void*)fused_fwd, hipFuncAttributeMaxDynamicSharedMemorySize, LDS_BYTES) != hipSuccess) { fprintf(stderr, "hipFuncSetAttribute failed\n"); grid = -1; return; }
        grid = cus;
    }
    if (grid < 0) return;
    (void)hipMemsetAsync((char*)d_ws + WS_CTL, 0, 256 * 1024, stream);
    Args a{}; for (int i = 0; i < 23; ++i) a.in[i] = (const float*)d_in[i]; a.out = (float*)d_out; a.ws = (unsigned char*)d_ws;
#ifndef PROBE_PHASE
    a.ph_lo = 0; a.ph_hi = 10; a.bar_region = 0;
    hipLaunchKernelGGL(fused_fwd, dim3(grid), dim3(NWAVES * 64), LDS_BYTES, stream, a);
#else
#ifndef PROBE_SUB
#define PROBE_SUB 0
#endif
    a.ph_lo = 0; a.ph_hi = PROBE_PHASE + 1; a.bar_region = 0; hipLaunchKernelGGL(fused_fwd, dim3(grid), dim3(NWAVES * 64), LDS_BYTES, stream, a);
    if (PROBE_SUB >= 1 && PROBE_SUB <= 3) { a.ph_lo = 10; a.ph_hi = 11; } else { a.ph_lo = PROBE_PHASE; a.ph_hi = PROBE_PHASE + 1; }
    a.bar_region = 1; hipLaunchKernelGGL(fused_fwd, dim3(grid), dim3(NWAVES * 64), LDS_BYTES, stream, a);
    if (PROBE_PHASE < 9) { a.ph_lo = PROBE_PHASE + 1; a.ph_hi = 10; a.bar_region = 2; hipLaunchKernelGGL(fused_fwd, dim3(grid), dim3(NWAVES * 64), LDS_BYTES, stream, a); }
#endif
}
```
